# Optimizing an MI355X kernel written in HIP

```python
import math
import numpy as np
import jax, jax.numpy as jnp
from jax import lax

D_MODEL = 1024
BATCH = 8
SEQ = 2048
DEPTH = 2

N_META = 16
EPS = 1e-6
A_HEADS = 4
A_HEAD_DIM = 64
A_WIDTH = A_HEADS * A_HEAD_DIM
A_DECAY_RANK = 64
A_ICLR_RANK = 64
A_GATE_RANK = 128
A_GN_EPS = 64e-5
A_DECAY_SCALE = 0.6065306597126334
A_COLS = (A_WIDTH, A_WIDTH, A_WIDTH, A_DECAY_RANK, A_DECAY_RANK, A_ICLR_RANK, A_ICLR_RANK, A_GATE_RANK)
A_TOTAL = 3 * A_WIDTH + 2 * A_DECAY_RANK + 2 * A_ICLR_RANK + A_GATE_RANK
B_HEADS = 4
B_QK_DIM = 64
B_V_DIM = 2 * B_QK_DIM
B_WIDTH = B_HEADS * B_V_DIM
B_COLS = (B_HEADS * 2 * B_QK_DIM, B_HEADS * 2 * B_QK_DIM, B_WIDTH)
B_TOTAL = 2 * B_HEADS * 2 * B_QK_DIM + B_WIDTH
Q_BLOCK = 128
ROPE_THETA = 10000.0
C_HEADS = 4
C_DK = 32
C_DV = 64
C_WIDTH = C_HEADS * C_DV
C_GATE_RANK = 16
C_GATE_TEMP = 16.0
C_CHUNK = 64
C_COLS = (C_HEADS * C_DK, C_HEADS * C_DK, C_WIDTH, C_WIDTH, C_GATE_RANK, C_GATE_RANK)
C_TOTAL = 2 * C_HEADS * C_DK + 2 * C_WIDTH + 2 * C_GATE_RANK
IN_COLS = A_TOTAL + B_TOTAL + C_TOTAL
MIX_WIDTH = A_WIDTH + B_WIDTH + C_WIDTH
N_EXPERTS = 16
EC_FACTOR = 2
EXPERT_FF = 1408

kernel_name = "hybrid_rwkv7_diffattn_gla_ec_moe_encoder"


def _split(x, sizes):
    idx = np.cumsum(sizes)[:-1].tolist()
    return jnp.split(x, idx, axis=-1)


def rms_norm(x, g, eps=EPS):
    xf = x.astype(jnp.float32)
    y = xf * lax.rsqrt(jnp.mean(xf * xf, axis=-1, keepdims=True) + eps)
    return (y * g.astype(jnp.float32)).astype(x.dtype)


def rotary(x, pos):
    half = x.shape[-1] // 2
    inv = ROPE_THETA ** (-jnp.arange(half, dtype=jnp.float32) / half)
    ang = pos[:, None] * inv[None, :]
    cos, sin = jnp.cos(ang), jnp.sin(ang)
    xf = x.astype(jnp.float32)
    x1, x2 = xf[..., :half], xf[..., half:]
    return jnp.concatenate([x1 * cos - x2 * sin, x2 * cos + x1 * sin], axis=-1).astype(x.dtype)


def centred_shift(p, mu):
    prev = jnp.pad(p, ((0, 0), (1, 0), (0, 0)))[:, :-1]
    nxt = jnp.pad(p, ((0, 0), (0, 1), (0, 0)))[:, 1:]
    return p + mu[0] * (prev - p) + mu[1] * (nxt - p)


def rwkv7_group(p, shift_mu, w0, w_up, a0, a_up, g_up, k_k, k_a, r_k, gn_g, gn_b):
    B, L, _ = p.shape
    f32 = jnp.float32
    p = centred_shift(p, shift_mu)
    r, k, v, wd_f, wd_b, ad_f, ad_b, gd = _split(p, A_COLS)
    heads = lambda t: t.reshape(t.shape[:-1] + (A_HEADS, A_HEAD_DIM))
    wd = jnp.stack([wd_f, wd_b])
    ad = jnp.stack([ad_f, ad_b])
    z_w = w0[:, None, None] + jnp.einsum("dblr,drc->dblc", jnp.tanh(wd), w_up)
    decay = jnp.exp(-A_DECAY_SCALE * jax.nn.sigmoid(z_w.astype(f32)))
    iclr = jax.nn.sigmoid((a0[:, None, None] + jnp.einsum("dblr,drc->dblc", ad, a_up)).astype(f32))
    gate = jnp.einsum("blr,rc->blc", jax.nn.sigmoid(gd), g_up)
    kk = heads((k * k_k).astype(f32))
    kk = kk / jnp.maximum(jnp.sqrt(jnp.sum(kk * kk, axis=-1, keepdims=True)), 1e-12)
    k_dir = heads(k.astype(f32)[None] * (1.0 + (iclr - 1.0) * k_a.astype(f32)))
    r_h, v_h = heads(r.astype(f32)), heads(v.astype(f32))
    both = lambda t: jnp.broadcast_to(t[None], (2,) + t.shape)

    def to_scan(t):
        t = jnp.stack([t[0], t[1][:, ::-1]])
        return jnp.moveaxis(t, 2, 0)

    xs = tuple(to_scan(t) for t in (both(r_h), heads(decay), k_dir, both(v_h), both(kk), both(kk) * heads(iclr)))

    def step(S, inp):
        r_t, w_t, k_t, v_t, kk_t, ka_t = inp
        sa = jnp.einsum("dbhvk,dbhk->dbhv", S, kk_t)
        S = S * w_t[..., None, :] - sa[..., :, None] * ka_t[..., None, :] + v_t[..., :, None] * k_t[..., None, :]
        return S, jnp.einsum("dbhvk,dbhk->dbhv", S, r_t)

    S0 = jnp.zeros((2, B, A_HEADS, A_HEAD_DIM, A_HEAD_DIM), f32)
    _, y = lax.scan(step, S0, xs)
    y = jnp.moveaxis(y, 0, 2)
    o = y[0] + y[1][:, ::-1]
    mu = jnp.mean(o, axis=-1, keepdims=True)
    var = jnp.mean(jnp.square(o - mu), axis=-1, keepdims=True)
    o = ((o - mu) * lax.rsqrt(var + A_GN_EPS)).reshape(B, L, A_WIDTH) * gn_g.astype(f32) + gn_b.astype(f32)
    bonus = jnp.sum(r_h[None] * k_dir * heads(r_k.astype(f32)), axis=-1, keepdims=True) * v_h[None]
    o = o + jnp.sum(bonus, axis=0).reshape(B, L, A_WIDTH)
    return (o * gate.astype(f32)).astype(p.dtype)


def diff_attention_group(p, pos, lam_p, subln_g, lam_init):
    B, L, _ = p.shape
    f32 = jnp.float32
    q, k, v = _split(p, B_COLS)
    q = rotary(q.reshape(B, L, B_HEADS, 2, B_QK_DIM).transpose(0, 2, 3, 1, 4), pos) * (B_QK_DIM ** -0.5)
    k = rotary(k.reshape(B, L, B_HEADS, 2, B_QK_DIM).transpose(0, 2, 3, 1, 4), pos)
    v = v.reshape(B, L, B_HEADS, B_V_DIM).transpose(0, 2, 1, 3)
    lam_p = lam_p.astype(f32)
    lam = jnp.exp(jnp.sum(lam_p[0] * lam_p[1])) - jnp.exp(jnp.sum(lam_p[2] * lam_p[3])) + lam_init

    def attend(qb):
        s = jnp.einsum("bhcqd,bhckd->bhcqk", qb, k).astype(f32)
        pr = jax.nn.softmax(s, axis=-1)
        w = pr[:, :, 0] - lam * pr[:, :, 1]
        return jnp.einsum("bhqk,bhkv->bhqv", w.astype(v.dtype), v)

    o_meta = attend(q[:, :, :, :N_META])
    n_blk = (L - N_META) // Q_BLOCK
    q_real = jnp.moveaxis(q[:, :, :, N_META:].reshape(B, B_HEADS, 2, n_blk, Q_BLOCK, B_QK_DIM), 3, 0)
    o_real = lax.map(attend, q_real)
    o_real = jnp.moveaxis(o_real, 0, 2).reshape(B, B_HEADS, n_blk * Q_BLOCK, B_V_DIM)
    o = jnp.concatenate([o_meta, o_real], axis=2)
    o = rms_norm(o, subln_g) * (1.0 - lam_init)
    return o.transpose(0, 2, 1, 3).reshape(B, L, B_WIDTH).astype(p.dtype)


def gla_chunked(q, k, v, log_a):
    B, H, T, dk = q.shape
    dv = v.shape[-1]
    n = T // C_CHUNK
    f32 = jnp.float32
    ch = lambda t: t.astype(f32).reshape(B, H, n, C_CHUNK, t.shape[-1])
    q, k, v, g = ch(q), ch(k), ch(v), ch(log_a)
    b = jnp.cumsum(g, axis=3)
    b_last = b[:, :, :, -1:, :]
    q_dec = q * jnp.exp(b)
    k_inv = k * jnp.exp(-b)
    k_end = k * jnp.exp(b_last - b)
    mask = jnp.tril(jnp.ones((C_CHUNK, C_CHUNK), dtype=bool))
    att = jnp.where(mask, jnp.einsum("bhntd,bhnsd->bhnts", q_dec, k_inv), 0.0)
    o = jnp.einsum("bhnts,bhnsv->bhntv", att, v)
    kv = jnp.einsum("bhnsd,bhnsv->bhndv", k_end, v)
    dec = jnp.exp(b_last[:, :, :, 0])

    def step(S, inp):
        dec_n, kv_n = inp
        return dec_n[..., None] * S + kv_n, S

    _, S_prev = lax.scan(step, jnp.zeros((B, H, dk, dv), f32), (jnp.moveaxis(dec, 2, 0), jnp.moveaxis(kv, 2, 0)))
    S_prev = jnp.moveaxis(S_prev, 0, 2)
    o = o + jnp.einsum("bhntd,bhndv->bhntv", q_dec, S_prev)
    return o.reshape(B, H, T, dv)


def gla_group(p, gate_up, gate_b, norm_g):
    B, L, _ = p.shape
    q, k, v, g, ad_f, ad_b = _split(p, C_COLS)
    heads_t = lambda t, d: t.reshape(B, L, C_HEADS, d).transpose(0, 2, 1, 3)
    q = heads_t(q, C_DK) * (C_DK ** -0.5)
    k = heads_t(k, C_DK)
    v = heads_t(v, C_DV)
    ad = jnp.stack([ad_f, ad_b])
    z = jnp.einsum("dblr,drc->dblc", ad, gate_up) + gate_b[:, None, None]
    log_a = jax.nn.log_sigmoid(z.astype(jnp.float32)) / C_GATE_TEMP
    la_f, la_b = heads_t(log_a[0], C_DK), heads_t(log_a[1], C_DK)
    pad = C_CHUNK - N_META
    padt = lambda t: jnp.pad(t, ((0, 0), (0, 0), (pad, 0), (0, 0)))
    flip = lambda t: t[:, :, ::-1]
    qp, kp, vp = padt(q), padt(k), padt(v)
    o_f = gla_chunked(qp, kp, vp, padt(la_f))
    o_b = flip(gla_chunked(flip(qp), flip(kp), flip(vp), flip(padt(la_b))))
    o = (o_f + o_b)[:, :, pad:]
    o = rms_norm(o.transpose(0, 2, 1, 3), norm_g).reshape(B, L, C_WIDTH)
    return (o * jax.nn.silu(g.astype(jnp.float32))).astype(p.dtype)


def expert_choice_ffn(u, router, w1, w3, w2):
    B, L, D = u.shape
    cap = EC_FACTOR * L // N_EXPERTS
    aff = jax.nn.softmax(jnp.einsum("bld,de->ble", u, router).astype(jnp.float32), axis=-1)
    gates, idx = lax.top_k(jnp.swapaxes(aff, 1, 2), cap)
    xs = jax.vmap(lambda ub, ib: ub[ib])(u, idx)
    hid = jax.nn.silu(jnp.einsum("becd,edf->becf", xs, w1)) * jnp.einsum("becd,edf->becf", xs, w3)
    ys = jnp.einsum("becf,efd->becd", hid, w2) * gates[..., None].astype(u.dtype)
    return jax.vmap(lambda yb, ib: jnp.zeros((L, D), yb.dtype).at[ib].add(yb))(ys, idx)


def setup_inputs(seed: int = 0) -> dict:
    key = jax.random.key(seed)
    ks = iter(jax.random.split(key, 32))
    nrm = lambda shape, scale: jax.random.normal(next(ks), shape, jnp.float32) * scale
    gain = lambda shape: 1.0 + nrm(shape, 0.02)
    D = D_MODEL
    return {
        "x": nrm((BATCH, SEQ, D), 1.0),
        "meta": nrm((N_META, D), 1.0),
        "norm1_g": gain((DEPTH, D)),
        "w_in": nrm((DEPTH, D, IN_COLS), D ** -0.5),
        "rw_shift": jax.random.uniform(next(ks), (DEPTH, 2, A_TOTAL), jnp.float32, 0.0, 0.5),
        "rw_w0": nrm((DEPTH, 2, A_WIDTH), 1.0),
        "rw_w_up": nrm((DEPTH, 2, A_DECAY_RANK, A_WIDTH), A_DECAY_RANK ** -0.5),
        "rw_a0": nrm((DEPTH, 2, A_WIDTH), 0.5),
        "rw_a_up": nrm((DEPTH, 2, A_ICLR_RANK, A_WIDTH), A_ICLR_RANK ** -0.5),
        "rw_g_up": nrm((DEPTH, A_GATE_RANK, A_WIDTH), A_GATE_RANK ** -0.5),
        "rw_k_k": 0.85 + nrm((DEPTH, A_WIDTH), 0.05),
        "rw_k_a": 1.0 + nrm((DEPTH, A_WIDTH), 0.05),
        "rw_r_k": nrm((DEPTH, A_WIDTH), 0.1),
        "rw_gn_g": gain((DEPTH, A_WIDTH)),
        "rw_gn_b": nrm((DEPTH, A_WIDTH), 0.02),
        "df_lam": nrm((DEPTH, 4, B_QK_DIM), 0.1),
        "df_subln_g": gain((DEPTH, B_V_DIM)),
        "gl_gate_up": nrm((DEPTH, 2, C_GATE_RANK, C_HEADS * C_DK), C_GATE_RANK ** -0.5),
        "gl_gate_b": nrm((DEPTH, 2, C_HEADS * C_DK), 0.5),
        "gl_norm_g": gain((DEPTH, C_DV)),
        "w_out": nrm((DEPTH, MIX_WIDTH, D), MIX_WIDTH ** -0.5),
        "norm2_g": gain((DEPTH, D)),
        "router": nrm((DEPTH, D, N_EXPERTS), D ** -0.5),
        "e_w1": nrm((DEPTH, N_EXPERTS, D, EXPERT_FF), D ** -0.5),
        "e_w3": nrm((DEPTH, N_EXPERTS, D, EXPERT_FF), D ** -0.5),
        "e_w2": nrm((DEPTH, N_EXPERTS, EXPERT_FF, D), EXPERT_FF ** -0.5),
        "final_g": gain((D,)),
    }


def reference(x, meta, norm1_g, w_in, rw_shift, rw_w0, rw_w_up, rw_a0, rw_a_up, rw_g_up, rw_k_k, rw_k_a,
              rw_r_k, rw_gn_g, rw_gn_b, df_lam, df_subln_g, gl_gate_up, gl_gate_b, gl_norm_g, w_out,
              norm2_g, router, e_w1, e_w3, e_w2, final_g):
    B = x.shape[0]
    h = jnp.concatenate([jnp.broadcast_to(meta[None].astype(x.dtype), (B, N_META, D_MODEL)), x], axis=1)
    L = h.shape[1]
    pos = jnp.arange(L, dtype=jnp.float32)
    for l in range(DEPTH):
        lam_init = 0.8 - 0.6 * math.exp(-0.3 * l)
        u = rms_norm(h, norm1_g[l])
        p = jnp.einsum("bld,dp->blp", u, w_in[l])
        p_a, p_b, p_c = _split(p, (A_TOTAL, B_TOTAL, C_TOTAL))
        y_a = rwkv7_group(p_a, rw_shift[l], rw_w0[l], rw_w_up[l], rw_a0[l], rw_a_up[l], rw_g_up[l],
                          rw_k_k[l], rw_k_a[l], rw_r_k[l], rw_gn_g[l], rw_gn_b[l])
        y_b = diff_attention_group(p_b, pos, df_lam[l], df_subln_g[l], lam_init)
        y_c = gla_group(p_c, gl_gate_up[l], gl_gate_b[l], gl_norm_g[l])
        mix = jnp.concatenate([y_a, y_b, y_c], axis=-1).astype(h.dtype)
        h = h + jnp.einsum("blc,cd->bld", mix, w_out[l])
        h = h + expert_choice_ffn(rms_norm(h, norm2_g[l]), router[l], e_w1[l], e_w3[l], e_w2[l])
    return rms_norm(h, final_g)[:, N_META:]
```

```cpp
#include <hip/hip_runtime.h>
#include <hip/hip_cooperative_groups.h>
#include <cstdio>
namespace cg = cooperative_groups;

#define LAS __attribute__((address_space(3)))
typedef unsigned short bf16_t;
typedef short bf16x8 __attribute__((ext_vector_type(8)));
typedef short bf16x4 __attribute__((ext_vector_type(4)));
typedef float f32x4 __attribute__((ext_vector_type(4)));
typedef float f32x16 __attribute__((ext_vector_type(16)));
typedef unsigned u32x4 __attribute__((ext_vector_type(4)));
typedef unsigned u32x2 __attribute__((ext_vector_type(2)));

constexpr int D = 1024, NB = 8, SEQ = 2048, NMETA = 16, L = 2064, BL = NB * L  , MP = 16640  ;
constexpr int A_TOT = 1152, B_TOT = 1536, C_TOT = 800, INC = 3488, INP = 3584, PACW = 1952;
constexpr int NE = 16, CAP = 258, FF = 1408, EM = 2304  , ES = 2064  ;
constexpr int LQ = 2304;
constexpr int SC_NQ = 524;
constexpr size_t SC_VF = (size_t)SC_NQ * 64 * 4 * 4, SC_VH = (size_t)SC_NQ * 64 * 4 * 2, SC_BH = 5 * SC_VF + 4 * SC_VH;
constexpr int NWAVES = 8, NTHREADS = 512;
constexpr int LDS_MAIN = 147456;
constexpr int LDS_BYTES = LDS_MAIN + 64;
constexpr int RWC_BYTES = 25600, RW_NCH = 65;

constexpr size_t al256(size_t x) { return (x + 255) & ~(size_t)255; }
constexpr size_t WS_CTL = 0;
constexpr size_t WS_H = 65536;
constexpr size_t WS_U = WS_H + al256((size_t)BL * D * 4);
constexpr size_t WS_WIN = WS_U + al256((size_t)MP * D * 2);
constexpr size_t WS_WOUT = WS_WIN + al256((size_t)2 * INP * D * 2);
constexpr size_t WS_W13 = WS_WOUT + al256((size_t)2 * D * D * 2);
constexpr size_t WS_W2 = WS_W13 + al256((size_t)NE * 2816 * D * 2);
constexpr size_t WS_AFF = WS_W2 + al256((size_t)NE * D * FF * 2);
constexpr size_t WS_IDX = WS_AFF + al256((size_t)NB * NE * L * 4);
constexpr size_t WS_GATEW = WS_IDX + al256((size_t)NE * EM * 4);
constexpr size_t WS_SEL = WS_GATEW + al256((size_t)NE * EM * 4);
constexpr size_t WS_BONUS = WS_SEL + al256((size_t)BL * NE * 4);
constexpr size_t WS_R = WS_BONUS + al256((size_t)BL * 4 * 4);
constexpr size_t R_PAC = WS_R;
constexpr size_t R_PB = R_PAC + al256((size_t)BL * PACW * 4);
constexpr size_t R_QR = R_PB + al256((size_t)BL * B_TOT * 2);
constexpr size_t R_KR = R_QR + al256((size_t)NB * 4 * 2 * LQ * 64 * 2);
constexpr size_t R_VT = R_KR + al256((size_t)NB * 4 * 2 * LQ * 64 * 2);
constexpr size_t R_SCANIN = R_VT + al256((size_t)NB * 4 * 128 * LQ * 2);
constexpr size_t R_YS2 = R_SCANIN + al256((size_t)NB * 4 * SC_BH);
constexpr size_t R_GATE = R_YS2 + al256((size_t)2 * BL * 256 * 4);
constexpr size_t R_GLAIN = R_GATE + al256((size_t)BL * 256 * 2);
constexpr size_t R_GKV = R_GLAIN + al256((size_t)NB * 4 * L * 128 * 4);
constexpr size_t R_GDEC = R_GKV + al256((size_t)NB * 4 * 33 * 2 * 2048 * 4);
constexpr size_t R_END = R_GDEC + al256((size_t)NB * 4 * 33 * 2 * 32 * 4);
constexpr size_t R_XS = WS_R;
constexpr size_t R_HID = R_XS + al256((size_t)NE * EM * D * 2);
constexpr size_t R_YS = R_HID + al256((size_t)NE * EM * FF * 2);
constexpr size_t R_END2 = R_YS + al256((size_t)NE * EM * D * 2);
constexpr size_t WS_LORA = R_END > R_END2 ? R_END : R_END2;
constexpr size_t WS_END = WS_LORA + 2 * 196608;
constexpr size_t WS_RWC = WS_W13;
static_assert((size_t)64 * RW_NCH * RWC_BYTES <= WS_AFF - WS_W13, "RWKV chunk images must fit the expert-weight region");

struct Params {
    const float *x, *meta, *norm1_g, *w_in, *rw_shift, *rw_w0, *rw_w_up, *rw_a0, *rw_a_up, *rw_g_up, *rw_k_k, *rw_k_a, *rw_r_k, *rw_gn_g, *rw_gn_b,
        *df_lam, *df_subln_g, *gl_gate_up, *gl_gate_b, *gl_norm_g, *w_out, *norm2_g, *router, *e_w1, *e_w3, *e_w2, *final_g;
    float* out; unsigned char* ws; int ph_lo, ph_hi;
};

#define GAS __attribute__((address_space(1)))
__device__ __forceinline__ u32x4 gload16(const void* p) { return *(const GAS u32x4*)(const GAS void*)p; }
__device__ __forceinline__ u32x2 gload8(const void* p) { return *(const GAS u32x2*)(const GAS void*)p; }
__device__ __forceinline__ f32x4 gload16f(const void* p) { return *(const GAS f32x4*)(const GAS void*)p; }
__device__ __forceinline__ int tid_opaque() { int t = threadIdx.x; asm volatile("" : "+v"(t)); return t; }
typedef __bf16 bf2_t __attribute__((ext_vector_type(2)));
typedef float f32x2 __attribute__((ext_vector_type(2)));
__device__ __forceinline__ unsigned pack2(float lo, float hi) { const f32x2 v = {lo, hi}; return __builtin_bit_cast(unsigned, __builtin_convertvector(v, bf2_t)); }
__device__ __forceinline__ bf16_t f2bf(float f) { return (bf16_t)(pack2(f, 0.f) & 0xffffu); }
__device__ __forceinline__ float bf2f(bf16_t b) { return __uint_as_float(((unsigned)b) << 16); }
__device__ __forceinline__ float rcp_(float x) { return __builtin_amdgcn_rcpf(x); }
__device__ __forceinline__ float sigmoidf_(float x) { return rcp_(1.0f + __expf(-x)); }
__device__ __forceinline__ float wave_sum_dpp(float v) {
    v += __int_as_float(__builtin_amdgcn_update_dpp(0, __float_as_int(v), 0xB1, 0xF, 0xF, false));
    v += __int_as_float(__builtin_amdgcn_update_dpp(0, __float_as_int(v), 0x4E, 0xF, 0xF, false));
    v += __int_as_float(__builtin_amdgcn_update_dpp(0, __float_as_int(v), 0x141, 0xF, 0xF, false));
    v += __int_as_float(__builtin_amdgcn_update_dpp(0, __float_as_int(v), 0x140, 0xF, 0xF, false));
    v += __int_as_float(__builtin_amdgcn_update_dpp(0, __float_as_int(v), 0x142, 0xA, 0xF, false));
    v += __int_as_float(__builtin_amdgcn_update_dpp(0, __float_as_int(v), 0x143, 0xC, 0xF, false));
    return __int_as_float(__builtin_amdgcn_readlane(__float_as_int(v), 63));
}

__device__ __forceinline__ f32x16 zero16() { f32x16 z;
#pragma unroll
    for (int i = 0; i < 16; ++i) z[i] = 0.f;
    return z; }
#define MFMA32(a, b, c) __builtin_amdgcn_mfma_f32_32x32x16_bf16((a), (b), (c), 0, 0, 0)

constexpr size_t WS_QCTR2 = 16384;
constexpr size_t WS_QCTR = 14336;
__device__ __forceinline__ int q_next(unsigned* ctr, LAS unsigned char* lds) {
    volatile LAS int* slot = (volatile LAS int*)(lds + LDS_MAIN + 32);
    __syncthreads();
    if (threadIdx.x == 0) *slot = (int)__hip_atomic_fetch_add(ctr, 1u, __ATOMIC_RELAXED, __HIP_MEMORY_SCOPE_AGENT);
    __syncthreads();
    return __builtin_amdgcn_readfirstlane(*slot);
}
__device__ __forceinline__ float wave_sum_all(float v) { return wave_sum_dpp(v); }

__device__ __forceinline__ float dppq1(float v) { return __int_as_float(__builtin_amdgcn_update_dpp(0, __float_as_int(v), 0xB1, 0xF, 0xF, false)); }
__device__ __forceinline__ float dppq2(float v) { return __int_as_float(__builtin_amdgcn_update_dpp(0, __float_as_int(v), 0x4E, 0xF, 0xF, false)); }
__device__ __forceinline__ float dpphm(float v) { return __int_as_float(__builtin_amdgcn_update_dpp(0, __float_as_int(v), 0x141, 0xF, 0xF, false)); }
__device__ __forceinline__ float dpprm(float v) { return __int_as_float(__builtin_amdgcn_update_dpp(0, __float_as_int(v), 0x140, 0xF, 0xF, false)); }
__device__ __forceinline__ float xchg16(float v, bool up) { const auto sw = __builtin_amdgcn_permlane16_swap(__float_as_uint(v), __float_as_uint(v), false, false); return __uint_as_float(up ? sw[0] : sw[1]); }
__device__ __forceinline__ float xchg32(float v, bool up) { const auto sw = __builtin_amdgcn_permlane32_swap(__float_as_uint(v), __float_as_uint(v), false, false); return __uint_as_float(up ? sw[0] : sw[1]); }
__device__ __forceinline__ float max3_(float a, float b, float c) { float d; asm("v_max3_f32 %0, %1, %2, %3" : "=v"(d) : "v"(a), "v"(b), "v"(c)); return d; }
__device__ __forceinline__ float sum16(float v) { v += dppq1(v); v += dppq2(v); v += dpphm(v); v += dpprm(v); return v; }

namespace pg8 {
constexpr int BM = 256, BK = 64, HALF = 128, HTB = HALF * BK * 2, STAGE_BYTES = 8 * HTB, NXCD = 8, WGM = 8;
__device__ __forceinline__ int lds_byte(int r, int c) { const int st = (r >> 4) * 2 + (c >> 5), rr = r & 15, cc = c & 31, ob = rr * 64 + cc * 2; return st * 1024 + (ob ^ (((ob >> 9) & 1) << 5)); }
__device__ __forceinline__ void stage_rc(int b, int& R, int& C) { const int st = b / 1024, sb = b % 1024, swz = sb ^ (((sb >> 9) & 1) << 5); R = (st >> 1) * 16 + swz / 64; C = (st & 1) * 32 + (swz % 64) / 2; }
__device__ __forceinline__ int perm32(int rho) { const int n = rho >> 4, i = rho & 15; return 8 * (i >> 2) + 4 * n + (i & 3); }
struct Unit { int pm, pn; };
struct Gemm { const bf16_t* A; const bf16_t* Bt; int M, N, K; };
struct StaticOrder {
    int nM, nN, nwg, G, c;
    __device__ void init(int M, int N, int G_, int c_) { nM = M / BM; nN = N / BM; nwg = nM * nN; G = G_; c = c_; }
    __device__ bool next(int i, Unit& u) const {
        const long Lx = (long)i * G + c; if (Lx >= nwg) return false;
        int wgid = (int)Lx; { const int q = nwg / NXCD, r = nwg % NXCD, xcd = wgid % NXCD, off = wgid / NXCD; wgid = (xcd < r ? xcd * (q + 1) : r * (q + 1) + (xcd - r) * q) + off; }
        const int nig = WGM * nN, gid = wgid / nig, fm = gid * WGM, gsz = (nM - fm) < WGM ? (nM - fm) : WGM;
        u.pm = fm + ((wgid % nig) % gsz); u.pn = (wgid % nig) / gsz; return true;
    }
};
struct GroupOrder {
    int nm, nn, ms, mb, total, G, c, gpx, spx, slot, xcd;
    __device__ void init(int ng, int nm_, int nn_, int ms_, int mb_, int G_, int c_) { nm = nm_; nn = nn_; ms = ms_; mb = mb_; total = ng * nm_ * nn_; G = G_; c = c_;
        gpx = ((G_ & 7) == 0 && (ng & 7) == 0 && nm_ % mb_ == 0) ? ng / 8 : 0; spx = G_ / 8; slot = c_ / 8; xcd = c_ & 7; }
    __device__ bool next(int i, Unit& u) const {
        const int per = nm * nn;
        if (gpx) {
            const int idx = i * spx + slot; if (idx >= gpx * per) return false;
            const int el = idx / per, rem = idx - el * per, e = xcd * gpx + el;
            const int mg = rem / (mb * nn), r2 = rem - mg * mb * nn, n = r2 / mb, m = mg * mb + (r2 - n * mb);
            u.pm = e * ms + m; u.pn = e * nn + n; return true;
        }
        const int Lx = i * G + c; if (Lx >= total) return false;
        const int e = Lx / per, rem = Lx - e * per, n = rem / nm, m = rem - n * nm;
        u.pm = e * ms + m; u.pn = e * nn + n; return true;
    }
};

template <class Epi, class Sched>
__device__ __forceinline__ void gemm_phase(LAS unsigned char* lds, const Gemm g, const Sched& S, const Epi& E) {
    const int tid = tid_opaque(), wid = __builtin_amdgcn_readfirstlane(tid >> 6), lane = tid & 63, wr = wid >> 2, wc = wid & 3, fr = lane & 15, fq = lane >> 4;
    const int K = g.K, nt = K / BK;
    unsigned voffA[2], voffB[2];
#pragma unroll
    for (int i = 0; i < 2; ++i) { int R, C; stage_rc(tid * 16 + i * 8192, R, C); const int Rb = Epi::PERM ? ((R & ~31) + perm32(R & 31)) : R;
        voffA[i] = (unsigned)(R * K + C) * 2u; voffB[i] = (unsigned)(Rb * K + C) * 2u; }
    const size_t kstep = (size_t)(BK * 2);
    const size_t hstep = (size_t)HALF * K * 2;
    const size_t tstep = 2 * hstep;
    const unsigned ldsw = (unsigned)wid * 1024u;
    const int aoff = lds_byte(wr * 64 + fr, fq * 8), boff = lds_byte(wc * 32 + fr, fq * 8);
#define PG8_SA(b, h) (((b) * 2 + (h)) * HTB)
#define PG8_SB(b, h) ((4 + (b) * 2 + (h)) * HTB)
#define PG8_STAGE(bufoff, gbase, voff) do { _Pragma("unroll") for (int _i = 0; _i < 2; ++_i) \
        __builtin_amdgcn_global_load_lds((const unsigned*)((const char*)(gbase) + (voff)[_i]), (LAS unsigned*)(lds + (bufoff) + ldsw + _i * 8192), 16, 0, 0); } while (0)
#define PG8_LDA(dst, b, h) do { _Pragma("unroll") for (int m = 0; m < 4; ++m) _Pragma("unroll") for (int k = 0; k < 2; ++k) dst[m][k] = *(const LAS bf16x8*)(lds + PG8_SA(b, h) + aoff + m * 2048 + k * 1024); } while (0)
#define PG8_LDB(dst, b, h) do { _Pragma("unroll") for (int n = 0; n < 2; ++n) _Pragma("unroll") for (int k = 0; k < 2; ++k) dst[n][k] = *(const LAS bf16x8*)(lds + PG8_SB(b, h) + boff + n * 2048 + k * 1024); } while (0)
#define PG8_MMA(ai, bj, At, Bt) do { __builtin_amdgcn_s_setprio(1); _Pragma("unroll") for (int m = 0; m < 4; ++m) _Pragma("unroll") for (int n = 0; n < 2; ++n) _Pragma("unroll") for (int k = 0; k < 2; ++k) \
        acc[ai][bj][m][n] = __builtin_amdgcn_mfma_f32_16x16x32_bf16(Bt[n][k], At[m][k], acc[ai][bj][m][n], 0, 0, 0); __builtin_amdgcn_s_setprio(0); } while (0)
#define PG8_WAIT_V(n) asm volatile("s_waitcnt vmcnt(" #n ")" ::: "memory")
#define PG8_WAIT_L(n) asm volatile("s_waitcnt lgkmcnt(" #n ")" ::: "memory")
#define PG8_BAR __builtin_amdgcn_s_barrier()
#define PG8_SCHED __builtin_amdgcn_sched_barrier(0)
    Unit cur, nxt; int ui = 0;
    if (!S.next(0, cur)) return;
    f32x4 acc[2][2][4][2];
#pragma unroll
    for (int a = 0; a < 2; ++a)
#pragma unroll
        for (int b = 0; b < 2; ++b)
#pragma unroll
            for (int m = 0; m < 4; ++m)
#pragma unroll
                for (int n = 0; n < 2; ++n) acc[a][b][m][n] = (f32x4){0.f, 0.f, 0.f, 0.f};
    bf16x8 At[4][2], B0[2][2], B1[2][2];
    const char* cA = (const char*)g.A + (size_t)cur.pm * tstep; const char* cB = (const char*)g.Bt + (size_t)cur.pn * tstep;
    PG8_STAGE(PG8_SB(0, 0), cB, voffB); PG8_STAGE(PG8_SA(0, 0), cA, voffA); PG8_STAGE(PG8_SB(0, 1), cB + hstep, voffB); PG8_STAGE(PG8_SA(0, 1), cA + hstep, voffA);
    if (wr == 1) PG8_BAR;
    PG8_WAIT_V(4); PG8_BAR;
    PG8_STAGE(PG8_SB(1, 0), cB + kstep, voffB); PG8_STAGE(PG8_SA(1, 0), cA + kstep, voffA); PG8_STAGE(PG8_SB(1, 1), cB + hstep + kstep, voffB);
    PG8_WAIT_V(6); PG8_BAR;
    for (;;) {
        const bool has_next = S.next(ui + 1, nxt);
        const char* nA = has_next ? (const char*)g.A + (size_t)nxt.pm * tstep : cA; const char* nB = has_next ? (const char*)g.Bt + (size_t)nxt.pn * tstep : cB;
        for (int t = 0; t < nt; t += 2) {
            const bool last = (t == nt - 2);
            const char* a1 = cA + (size_t)(t + 1) * kstep;
            const char* a2 = last ? nA : cA + (size_t)(t + 2) * kstep; const char* b2 = last ? nB : cB + (size_t)(t + 2) * kstep;
            const char* a3 = a2 + kstep; const char* b3 = b2 + kstep;
            PG8_LDB(B0, 0, 0); PG8_SCHED; PG8_LDA(At, 0, 0); PG8_STAGE(PG8_SA(1, 1), a1 + hstep, voffA);
            PG8_WAIT_L(8); PG8_BAR; PG8_WAIT_L(0); PG8_MMA(0, 0, At, B0); PG8_BAR; PG8_SCHED;
            PG8_LDB(B1, 0, 1); PG8_STAGE(PG8_SB(0, 0), b2, voffB);
            PG8_BAR; PG8_WAIT_L(0); PG8_MMA(0, 1, At, B1); PG8_BAR;
            PG8_LDA(At, 0, 1); PG8_STAGE(PG8_SA(0, 0), a2, voffA);
            PG8_BAR; PG8_WAIT_L(0); PG8_MMA(1, 0, At, B0); PG8_BAR; PG8_SCHED;
            PG8_STAGE(PG8_SB(0, 1), b2 + hstep, voffB);
            PG8_WAIT_V(6); PG8_BAR; PG8_MMA(1, 1, At, B1); PG8_BAR;
            PG8_LDB(B0, 1, 0); PG8_SCHED; PG8_LDA(At, 1, 0); PG8_STAGE(PG8_SA(0, 1), a2 + hstep, voffA);
            PG8_WAIT_L(8); PG8_BAR; PG8_WAIT_L(0); PG8_MMA(0, 0, At, B0); PG8_BAR; PG8_SCHED;
            PG8_LDB(B1, 1, 1); PG8_STAGE(PG8_SB(1, 0), b3, voffB);
            PG8_BAR; PG8_WAIT_L(0); PG8_MMA(0, 1, At, B1); PG8_BAR;
            PG8_LDA(At, 1, 1); PG8_STAGE(PG8_SA(1, 0), a3, voffA);
            PG8_BAR; PG8_WAIT_L(0); PG8_MMA(1, 0, At, B0); PG8_BAR; PG8_SCHED;
            PG8_STAGE(PG8_SB(1, 1), b3 + hstep, voffB);
            PG8_WAIT_V(6); PG8_BAR; PG8_MMA(1, 1, At, B1); PG8_BAR;
        }
        E(acc, cur, wr, wc, fr, fq);
        if (!has_next) break;
#pragma unroll
        for (int a = 0; a < 2; ++a)
#pragma unroll
            for (int b = 0; b < 2; ++b)
#pragma unroll
                for (int m = 0; m < 4; ++m)
#pragma unroll
                    for (int n = 0; n < 2; ++n) acc[a][b][m][n] = (f32x4){0.f, 0.f, 0.f, 0.f};
        cur = nxt; cA = nA; cB = nB; ++ui;
    }
    PG8_WAIT_V(0);
    if (wr == 0) PG8_BAR;
    PG8_BAR;
#undef PG8_SA
#undef PG8_SB
#undef PG8_STAGE
#undef PG8_LDA
#undef PG8_LDB
#undef PG8_MMA
#undef PG8_WAIT_V
#undef PG8_WAIT_L
#undef PG8_BAR
#undef PG8_SCHED
}
}

struct EpiInproj {
    static constexpr bool PERM = false;
    float* pac; bf16_t* pb;
    __device__ __forceinline__ void operator()(const f32x4 (&acc)[2][2][4][2], const pg8::Unit& u, int wr, int wc, int fr, int fq) const {
        const int row0 = u.pm * 256 + wr * 64 + fr, col0 = u.pn * 256 + wc * 32 + 4 * fq;
#pragma unroll
        for (int ai = 0; ai < 2; ++ai)
#pragma unroll
            for (int m = 0; m < 4; ++m) {
                const int row = row0 + ai * 128 + m * 16;
                if (row < BL) {
#pragma unroll
                    for (int bj = 0; bj < 2; ++bj)
#pragma unroll
                        for (int n = 0; n < 2; ++n) {
                            const int c = col0 + bj * 128 + n * 16; const f32x4 v = acc[ai][bj][m][n];
                            if (c < A_TOT) *(f32x4*)(pac + (size_t)row * PACW + c) = v;
                            else if (c < A_TOT + B_TOT) { u32x2 w; w.x = pack2(v[0], v[1]); w.y = pack2(v[2], v[3]); *(u32x2*)(pb + (size_t)row * B_TOT + (c - A_TOT)) = w; }
                            else if (c < INC) *(f32x4*)(pac + (size_t)row * PACW + A_TOT + (c - A_TOT - B_TOT)) = v;
                        }
                }
            }
    }
};
struct EpiResidual {
    static constexpr bool PERM = false;
    float* h;
    __device__ __forceinline__ void operator()(const f32x4 (&acc)[2][2][4][2], const pg8::Unit& u, int wr, int wc, int fr, int fq) const {
        const int row0 = u.pm * 256 + wr * 64 + fr, col0 = u.pn * 256 + wc * 32 + 4 * fq;
#pragma unroll
        for (int ai = 0; ai < 2; ++ai)
#pragma unroll
            for (int m = 0; m < 4; ++m) {
                const int row = row0 + ai * 128 + m * 16;
                if (row < BL) {
#pragma unroll
                    for (int bj = 0; bj < 2; ++bj)
#pragma unroll
                        for (int n = 0; n < 2; ++n) { float* p = h + (size_t)row * D + col0 + bj * 128 + n * 16; *(f32x4*)p = *(const f32x4*)p + acc[ai][bj][m][n]; }
                }
            }
    }
};
struct EpiSwiglu {
    static constexpr bool PERM = true;
    bf16_t* hid;
    __device__ __forceinline__ void operator()(const f32x4 (&acc)[2][2][4][2], const pg8::Unit& u, int wr, int wc, int fr, int fq) const {
        const int e = u.pm / 9, pnl = u.pn - e * 11;
        const int row0 = u.pm * 256 + wr * 64 + fr, colf = pnl * 128 + wc * 32 + 8 * fq;
#pragma unroll
        for (int ai = 0; ai < 2; ++ai)
#pragma unroll
            for (int m = 0; m < 4; ++m) {
                const int row = row0 + ai * 128 + m * 16;
                float o[8];
#pragma unroll
                for (int n = 0; n < 2; ++n)
#pragma unroll
                    for (int j = 0; j < 4; ++j) { const float a = acc[ai][0][m][n][j], b = acc[ai][1][m][n][j]; o[n * 4 + j] = a * rcp_(1.0f + __expf(-a)) * b; }
                u32x4 w; w.x = pack2(o[0], o[1]); w.y = pack2(o[2], o[3]); w.z = pack2(o[4], o[5]); w.w = pack2(o[6], o[7]);
                *(u32x4*)(hid + (size_t)row * FF + colf) = w;
                asm volatile("" ::: "memory");
            }
    }
};
struct EpiDown {
    static constexpr bool PERM = true;
    bf16_t* ys; const float* gatew;
    __device__ __forceinline__ void operator()(const f32x4 (&acc)[2][2][4][2], const pg8::Unit& u, int wr, int wc, int fr, int fq) const {
        const int e = u.pm / 9, pnl = u.pn - e * 4, ml = u.pm - e * 9;
        const int rl0 = ml * 256 + wr * 64 + fr, col0 = pnl * 256 + wc * 32 + 8 * fq;
#pragma unroll
        for (int ai = 0; ai < 2; ++ai)
#pragma unroll
            for (int m = 0; m < 4; ++m) {
                const int rl = rl0 + ai * 128 + m * 16;
                if (rl < ES) {
                    const size_t row = (size_t)e * EM + rl; const float gw = gatew[row];
#pragma unroll
                    for (int bj = 0; bj < 2; ++bj) {
                        const f32x4 v0 = acc[ai][bj][m][0] * gw, v1 = acc[ai][bj][m][1] * gw;
                        u32x4 w; w.x = pack2(v0[0], v0[1]); w.y = pack2(v0[2], v0[3]); w.z = pack2(v1[0], v1[1]); w.w = pack2(v1[2], v1[3]);
                        *(u32x4*)(ys + row * D + col0 + bj * 128) = w;
                    }
                }
                asm volatile("" ::: "memory");
            }
    }
};

__device__ __forceinline__ void conv_tile(const float* __restrict__ src, int K, int N, bf16_t* __restrict__ dst, int k0, int n0, int nrow0, LAS bf16_t* sm, int lane) {
    const bool okc = n0 + lane < N;
#pragma unroll
    for (int half = 0; half < 2; ++half) {
        float v[32];
#pragma unroll
        for (int kk = 0; kk < 32; ++kk) v[kk] = okc ? __builtin_nontemporal_load(src + (size_t)(k0 + half * 32 + kk) * N + n0 + lane) : 0.f;
#pragma unroll
        for (int kk = 0; kk < 32; kk += 2) *(LAS unsigned*)(sm + lane * 68 + half * 32 + kk) = pack2(v[kk], v[kk + 1]);
    }
    asm volatile("" ::: "memory");
    const int rg = lane >> 3, ch = lane & 7;
#pragma unroll
    for (int ps = 0; ps < 8; ++ps) {
        const int row = ps * 8 + rg;
        const u32x2 a = *(const LAS u32x2*)(sm + row * 68 + ch * 8), c = *(const LAS u32x2*)(sm + row * 68 + ch * 8 + 4);
        if (n0 + row < N) *(u32x4*)(dst + (size_t)(nrow0 + row) * K + k0 + ch * 8) = (u32x4){a.x, a.y, c.x, c.y};
    }
    asm volatile("" ::: "memory");
}
__device__ __forceinline__ void conv_expert_tile(const Params& p, int layer, int r, LAS bf16_t* sm, int lane) {
    constexpr int T13 = 16 * 22, T2 = 22 * 16;
    unsigned char* ws = p.ws;
    const int e = r / (2 * T13 + T2); r -= e * (2 * T13 + T2);
    if (r < 2 * T13) {
        const int which = r / T13; r -= which * T13;
        const int kt = r / 22, ntile = r % 22, n0 = ntile * 64, k0 = kt * 64;
        const float* src = (which ? p.e_w3 : p.e_w1) + ((size_t)layer * NE + e) * (size_t)D * FF;
        bf16_t* dst = (bf16_t*)(ws + WS_W13) + (size_t)e * 2816 * D;
        conv_tile(src, D, FF, dst, k0, n0, (n0 >> 7) * 256 + (n0 & 127) + which * 128, sm, lane);
    } else {
        r -= 2 * T13;
        const int kt = r / 16, ntile = r % 16, n0 = ntile * 64, k0 = kt * 64;
        const float* src = p.e_w2 + ((size_t)layer * NE + e) * (size_t)FF * D;
        bf16_t* dst = (bf16_t*)(ws + WS_W2) + (size_t)e * D * FF;
        conv_tile(src, FF, D, dst, k0, n0, n0, sm, lane);
    }
}
constexpr int CONV_NTILES = NE * (2 * 16 * 22 + 22 * 16), CONV_CHUNK = 16, CONV_NCHUNK = CONV_NTILES / CONV_CHUNK;
__device__ __forceinline__ void conv_chunk(const Params& p, int layer, int chunk, LAS unsigned char* lds) {
    const int tid = tid_opaque(), wid = tid >> 6, lane = tid & 63;
    LAS bf16_t* sm = (LAS bf16_t*)(lds + wid * 8704);
#pragma unroll 1
    for (int q = 0; q < CONV_CHUNK / NWAVES; ++q) conv_expert_tile(p, layer, chunk * CONV_CHUNK + q * NWAVES + wid, sm, lane);
}
__device__ __forceinline__ void phase_conv(const Params& p, int layer, int what, LAS unsigned char* lds) {
    const int tid = tid_opaque(), wid = tid >> 6, lane = tid & 63;
    LAS bf16_t* sm = (LAS bf16_t*)(lds + wid * 8704);
    const int gw = blockIdx.x * NWAVES + wid, NGW = gridDim.x * NWAVES;
    unsigned char* ws = p.ws;
    constexpr int T13 = 16 * 22, T2 = 22 * 16;
    constexpr int NEXP = NE * (2 * T13 + T2);
    constexpr int TIN = 16 * 55, TOUT = 16 * 16;
    const int it0 = what ? 0 : NEXP, nit = what ? NEXP : NEXP + 2 * (TIN + TOUT) + 2 * 96 + 48;
    for (int it = it0 + gw; it < nit; it += NGW) {
        int r = it;
        if (r < NEXP) {
            const int e = r / (2 * T13 + T2); r -= e * (2 * T13 + T2);
            if (r < 2 * T13) {
                const int which = r / T13; r -= which * T13;
                const int kt = r / 22, ntile = r % 22, n0 = ntile * 64, k0 = kt * 64;
                const float* src = (which ? p.e_w3 : p.e_w1) + ((size_t)layer * NE + e) * (size_t)D * FF;
                bf16_t* dst = (bf16_t*)(ws + WS_W13) + (size_t)e * 2816 * D;
                conv_tile(src, D, FF, dst, k0, n0, (n0 >> 7) * 256 + (n0 & 127) + which * 128, sm, lane);
            } else {
                r -= 2 * T13;
                const int kt = r / 16, ntile = r % 16, n0 = ntile * 64, k0 = kt * 64;
                const float* src = p.e_w2 + ((size_t)layer * NE + e) * (size_t)FF * D;
                bf16_t* dst = (bf16_t*)(ws + WS_W2) + (size_t)e * D * FF;
                conv_tile(src, FF, D, dst, k0, n0, n0, sm, lane);
            }
            continue;
        }
        r -= NEXP;
        if (r < 2 * TIN) {
            const int ly = r / TIN; r -= ly * TIN;
            const int kt = r / 55, ntile = r % 55, n0 = ntile * 64, k0 = kt * 64;
            conv_tile(p.w_in + (size_t)ly * D * INC, D, INC, (bf16_t*)(ws + WS_WIN) + (size_t)ly * INP * D, k0, n0, n0, sm, lane);
            continue;
        }
        r -= 2 * TIN;
        if (r < 2 * TOUT) {
            const int ly = r / TOUT; r -= ly * TOUT;
            const int kt = r / 16, ntile = r % 16, n0 = ntile * 64, k0 = kt * 64;
            conv_tile(p.w_out + (size_t)ly * D * D, D, D, (bf16_t*)(ws + WS_WOUT) + (size_t)ly * D * D, k0, n0, n0, sm, lane);
            continue;
        }
        r -= 2 * TOUT;
        if (r >= 2 * 96) {
            r -= 2 * 96;
            const int ly = r / 24, q = r % 24;
            bf16_t* lb = (bf16_t*)(ws + WS_LORA) + (size_t)ly * 98304;
            if (q < 8) conv_tile(p.rw_w_up + ((size_t)ly * 2 + (q >> 2)) * 64 * 256, 64, 256, lb + (q >> 2) * 16384, 0, (q & 3) * 64, (q & 3) * 64, sm, lane);
            else if (q < 16) conv_tile(p.rw_a_up + ((size_t)ly * 2 + ((q - 8) >> 2)) * 64 * 256, 64, 256, lb + 32768 + ((q - 8) >> 2) * 16384, 0, (q & 3) * 64, (q & 3) * 64, sm, lane);
            else conv_tile(p.rw_g_up + (size_t)ly * 128 * 256, 128, 256, lb + 65536, ((q - 16) >> 2) * 64, (q & 3) * 64, (q & 3) * 64, sm, lane);
            continue;
        }
        {
            const int ly = r / 96, row = INC + r % 96;
            u32x4* d = (u32x4*)((bf16_t*)(ws + WS_WIN) + ((size_t)ly * INP + row) * D);
            d[lane] = (u32x4){0u, 0u, 0u, 0u}; d[lane + 64] = (u32x4){0u, 0u, 0u, 0u};
        }
    }
    __syncthreads();
}

__device__ __forceinline__ void phase_norm1(const Params& p, int layer, int mode) {
    const int tid = tid_opaque(), wid = tid >> 6, lane = tid & 63;
    const int gw = blockIdx.x * NWAVES + wid, NGW = gridDim.x * NWAVES;
    unsigned char* ws = p.ws;
    float* H = (float*)(ws + WS_H); bf16_t* U = (bf16_t*)(ws + WS_U);
    const int* SEL = (const int*)(ws + WS_SEL); const bf16_t* YS = (const bf16_t*)(ws + R_YS);
    const float* g = (mode == 2) ? p.final_g : p.norm1_g + (size_t)layer * D;
    const f32x4 gq[4] = {*(const f32x4*)(g + lane * 4), *(const f32x4*)(g + 256 + lane * 4), *(const f32x4*)(g + 512 + lane * 4), *(const f32x4*)(g + 768 + lane * 4)};
    f32x4 vn[4]; int sn_ = -1;
#define N1_FETCH(rw) do { const int r_ = (rw); if (r_ < BL) { const int b_ = r_ / L, l_ = r_ - b_ * L; \
        const float* src_ = (mode == 0) ? ((l_ < NMETA) ? p.meta + (size_t)l_ * D : p.x + ((size_t)b_ * SEQ + (l_ - NMETA)) * D) : H + (size_t)r_ * D; \
        _Pragma("unroll") for (int i = 0; i < 4; ++i) vn[i] = *(const f32x4*)(src_ + i * 256 + lane * 4); \
        if (mode != 0) sn_ = SEL[(size_t)r_ * NE + (lane & 15)]; } } while (0)
    N1_FETCH(gw);
    for (int row = gw; row < MP; row += NGW) {
        if (row >= BL) { if (mode != 2) { u32x2* d = (u32x2*)(U + (size_t)row * D); for (int i = 0; i < 4; ++i) d[i * 64 + lane] = (u32x2){0u, 0u}; } continue; }
        const int b = row / L, l = row - b * L;
        f32x4 v[4];
#pragma unroll
        for (int i = 0; i < 4; ++i) v[i] = vn[i];
        const int mys = sn_;
        N1_FETCH(row + NGW);
        if (mode == 2 && l < NMETA) continue;
        if (mode != 0) {
            unsigned rem = (unsigned)__ballot((lane < 16) && (mys >= 0)) & 0xffffu;
            while (rem) {
                u32x2 w[4][4];
#pragma unroll
                for (int q = 0; q < 4; ++q) {
                    if (rem) { const int e = __builtin_ctz(rem); rem &= rem - 1u; const int sl = __builtin_amdgcn_readlane(mys, e);
                        const bf16_t* yr = YS + ((size_t)e * EM + sl) * D;
#pragma unroll
                        for (int i = 0; i < 4; ++i) w[q][i] = *(const u32x2*)(yr + i * 256 + lane * 4); }
                    else {
#pragma unroll
                        for (int i = 0; i < 4; ++i) w[q][i] = (u32x2){0u, 0u}; }
                }
#pragma unroll
                for (int q = 0; q < 4; ++q)
#pragma unroll
                    for (int i = 0; i < 4; ++i) { v[i][0] += __uint_as_float(w[q][i].x << 16); v[i][1] += __uint_as_float(w[q][i].x & 0xffff0000u); v[i][2] += __uint_as_float(w[q][i].y << 16); v[i][3] += __uint_as_float(w[q][i].y & 0xffff0000u); }
            }
        }
        if (mode != 2) {
#pragma unroll
            for (int i = 0; i < 4; ++i) *(f32x4*)(H + (size_t)row * D + i * 256 + lane * 4) = v[i];
        }
        float ss = 0.f;
#pragma unroll
        for (int i = 0; i < 4; ++i) ss += v[i][0] * v[i][0] + v[i][1] * v[i][1] + v[i][2] * v[i][2] + v[i][3] * v[i][3];
        ss = wave_sum_all(ss);
        const float rs = rsqrtf(ss * (1.0f / D) + 1e-6f);
#pragma unroll
        for (int i = 0; i < 4; ++i) {
            const f32x4 o = v[i] * rs * gq[i];
            if (mode == 2) *(f32x4*)(p.out + ((size_t)b * SEQ + (l - NMETA)) * D + i * 256 + lane * 4) = o;
            else { u32x2 w; w.x = pack2(o[0], o[1]); w.y = pack2(o[2], o[3]); *(u32x2*)(U + (size_t)row * D + i * 256 + lane * 4) = w; }
        }
    }
#undef N1_FETCH
}

__device__ __forceinline__ void phase_norm2(const Params& p, int layer, LAS unsigned char* lds) {
    const int tid = tid_opaque(), wid = tid >> 6, lane = tid & 63;
    const int gw = blockIdx.x * NWAVES + wid, NGW = gridDim.x * NWAVES;
    unsigned char* ws = p.ws;
    const float* H = (const float*)(ws + WS_H); bf16_t* U = (bf16_t*)(ws + WS_U); float* AFF = (float*)(ws + WS_AFF);
    const float* g = p.norm2_g + (size_t)layer * D; const float* rt = p.router + (size_t)layer * D * NE;
    LAS float* RT = (LAS float*)lds;
    for (int idx = tid; idx < D * NE / 4; idx += NTHREADS) {
        const f32x4 w = *(const f32x4*)(rt + idx * 4); const int col = idx >> 2, e0 = (idx & 3) * 4;
        RT[(e0 + 0) * D + col] = w[0]; RT[(e0 + 1) * D + col] = w[1]; RT[(e0 + 2) * D + col] = w[2]; RT[(e0 + 3) * D + col] = w[3];
    }
    __syncthreads();
    const f32x4 gq[4] = {*(const f32x4*)(g + lane * 4), *(const f32x4*)(g + 256 + lane * 4), *(const f32x4*)(g + 512 + lane * 4), *(const f32x4*)(g + 768 + lane * 4)};
    f32x4 vn[4];
#pragma unroll
    for (int i = 0; i < 4; ++i) vn[i] = (gw < BL) ? *(const f32x4*)(H + (size_t)gw * D + i * 256 + lane * 4) : (f32x4){0.f, 0.f, 0.f, 0.f};
    for (int row = gw; row < BL; row += NGW) {
        const int b = row / L, l = row - b * L;
        f32x4 v[4];
#pragma unroll
        for (int i = 0; i < 4; ++i) v[i] = vn[i];
        { const int rn = (row + NGW < BL) ? row + NGW : row;
#pragma unroll
          for (int i = 0; i < 4; ++i) vn[i] = *(const f32x4*)(H + (size_t)rn * D + i * 256 + lane * 4); }
        float ss = 0.f;
#pragma unroll
        for (int i = 0; i < 4; ++i) ss += v[i][0] * v[i][0] + v[i][1] * v[i][1] + v[i][2] * v[i][2] + v[i][3] * v[i][3];
        ss = wave_sum_all(ss);
        const float rs = rsqrtf(ss * (1.0f / D) + 1e-6f);
        float lg[NE];
#pragma unroll
        for (int e = 0; e < NE; ++e) lg[e] = 0.f;
#pragma unroll
        for (int i = 0; i < 4; ++i) {
            const f32x4 o = v[i] * rs * gq[i];
            u32x2 w; w.x = pack2(o[0], o[1]); w.y = pack2(o[2], o[3]); *(u32x2*)(U + (size_t)row * D + i * 256 + lane * 4) = w;
#pragma unroll
            for (int e = 0; e < NE; ++e) { const f32x4 w4 = *(const LAS f32x4*)(RT + e * D + i * 256 + lane * 4); lg[e] += o[0] * w4[0] + o[1] * w4[1] + o[2] * w4[2] + o[3] * w4[3]; }
        }
        float r8[8], r4[4], r2[2], r1;
#pragma unroll
        for (int j = 0; j < 8; ++j) { const float a = lg[j], c2 = lg[8 + j]; const bool up = (lane & 32) != 0; r8[j] = (up ? c2 : a) + xchg32(up ? a : c2, up); }
#pragma unroll
        for (int j = 0; j < 4; ++j) { const float a = r8[j], c2 = r8[4 + j]; const bool up = (lane & 16) != 0; r4[j] = (up ? c2 : a) + xchg16(up ? a : c2, up); }
#pragma unroll
        for (int j = 0; j < 2; ++j) { const float a = r4[j], c2 = r4[2 + j]; const bool up = (lane & 8) != 0; r2[j] = (up ? c2 : a) + dpprm(up ? a : c2); }
        { const float a = r2[0], c2 = r2[1]; const bool up = (lane & 4) != 0; r1 = (up ? c2 : a) + dpphm(up ? a : c2); }
        r1 += dppq2(r1); r1 += dppq1(r1);
        float mx = r1;
        mx = fmaxf(mx, dpphm(mx)); mx = fmaxf(mx, dpprm(mx)); mx = fmaxf(mx, xchg16(mx, (lane & 16) != 0)); mx = fmaxf(mx, xchg32(mx, (lane & 32) != 0));
        const float ex = __expf(r1 - mx);
        float sum = ex;
        sum += dpphm(sum); sum += dpprm(sum); sum += xchg16(sum, (lane & 16) != 0); sum += xchg32(sum, (lane & 32) != 0);
        const float mine = ex / sum;
        const int eidx = ((lane >> 5) & 1) * 8 + ((lane >> 4) & 1) * 4 + ((lane >> 3) & 1) * 2 + ((lane >> 2) & 1);
        if ((lane & 3) == 0) AFF[((size_t)b * NE + eidx) * L + l] = mine;
    }
    __syncthreads();
}

__device__ __forceinline__ void phase_topk(const Params& p, LAS unsigned char* lds) {
    const int tid = tid_opaque(), wid = tid >> 6, lane = tid & 63;
    unsigned char* ws = p.ws;
    const float* AFF = (const float*)(ws + WS_AFF); int* IDX = (int*)(ws + WS_IDX); float* GATEW = (float*)(ws + WS_GATEW); int* SEL = (int*)(ws + WS_SEL);
    LAS int* wc = (LAS int*)lds;
    for (int it2 = blockIdx.x; it2 < 2 * NB * NE; it2 += gridDim.x) {
        const int item = it2 >> 1, half = it2 & 1, b = item / NE, e = item % NE;
        const float* a = AFF + ((size_t)b * NE + e) * L;
        unsigned u[5]; float f[5];
#pragma unroll
        for (int j = 0; j < 5; ++j) { const int i = tid + j * NTHREADS; f[j] = (i < L) ? a[i] : 0.f; u[j] = (i < L) ? __float_as_uint(f[j]) : 0u; }
        unsigned prefix = 0u;
        for (int bit = 30; bit >= 0; --bit) {
            const unsigned cand = prefix | (1u << bit);
            int c = 0;
#pragma unroll
            for (int j = 0; j < 5; ++j) c += __popcll(__ballot(u[j] >= cand));
            LAS int* w = wc + ((bit & 1) * 8);
            if (lane == 0) w[wid] = c;
            __syncthreads();
            int tot = 0;
#pragma unroll
            for (int q = 0; q < 8; ++q) tot += w[q];
            if (tot >= CAP) prefix = cand;
        }
        __syncthreads();
        LAS int* sc = wc + 64;
        LAS int* rowl = wc + 256;
        unsigned long long mgt[5], meq[5];
#pragma unroll
        for (int j = 0; j < 5; ++j) {
            const int i = tid + j * NTHREADS;
            mgt[j] = __ballot(i < L && u[j] > prefix); meq[j] = __ballot(i < L && u[j] == prefix);
            if (lane == 0) { sc[(0 * 5 + j) * 8 + wid] = __popcll(mgt[j]); sc[(1 * 5 + j) * 8 + wid] = __popcll(meq[j]); }
        }
        __syncthreads();
        int ngt = 0;
        for (int q = 0; q < 40; ++q) ngt += sc[q];
        const int need_eq = CAP - ngt;
        const unsigned long long lower = (lane == 0) ? 0ull : (~0ull >> (64 - lane));
        int base_gt = 0, base_eq = 0;
#pragma unroll
        for (int j = 0; j < 5; ++j) {
            const int i = tid + j * NTHREADS;
            int pg = base_gt, pe = base_eq;
            for (int q = 0; q < 8; ++q) { const int cg_ = sc[(0 * 5 + j) * 8 + q], ce_ = sc[(1 * 5 + j) * 8 + q]; if (q < wid) { pg += cg_; pe += ce_; } base_gt += cg_; base_eq += ce_; }
            pg += __popcll(mgt[j] & lower); pe += __popcll(meq[j] & lower);
            if (i < L) {
                int slot = -1;
                if (u[j] > prefix) slot = pg; else if (u[j] == prefix && pe < need_eq) slot = ngt + pe;
                const int row = b * L + i;
                if (half == 0) SEL[(size_t)row * NE + e] = (slot >= 0) ? b * CAP + slot : -1;
                if (slot >= 0) { if (half == 0) GATEW[e * EM + b * CAP + slot] = f[j]; rowl[slot] = row; }
            }
        }
        __syncthreads();
        for (int s0 = half * 129 + wid * 4; s0 < half * 129 + 129; s0 += NWAVES * 4) {
            u32x4 t0[4], t1[4];
#pragma unroll
            for (int q = 0; q < 4; ++q) { const int sl = (s0 + q < half * 129 + 129) ? s0 + q : s0; const u32x4* srcr = (const u32x4*)((const bf16_t*)(ws + WS_U) + (size_t)rowl[sl] * D); t0[q] = srcr[lane]; t1[q] = srcr[lane + 64]; }
#pragma unroll
            for (int q = 0; q < 4; ++q) if (s0 + q < half * 129 + 129) { u32x4* dstr = (u32x4*)((bf16_t*)(ws + R_XS) + (size_t)(e * EM + b * CAP + s0 + q) * D); dstr[lane] = t0[q]; dstr[lane + 64] = t1[q]; }
        }
        __syncthreads();
    }
}

__device__ __forceinline__ float half_sum32(float v) {
    v += __int_as_float(__builtin_amdgcn_update_dpp(0, __float_as_int(v), 0xB1, 0xF, 0xF, false));
    v += __int_as_float(__builtin_amdgcn_update_dpp(0, __float_as_int(v), 0x4E, 0xF, 0xF, false));
    v += __int_as_float(__builtin_amdgcn_update_dpp(0, __float_as_int(v), 0x141, 0xF, 0xF, false));
    v += __int_as_float(__builtin_amdgcn_update_dpp(0, __float_as_int(v), 0x140, 0xF, 0xF, false));
    v += xchg16(v, (threadIdx.x & 16) != 0);
    return v;
}
__device__ __forceinline__ void prep_a_item(const Params& p, int layer, int item, LAS unsigned char* lds) {
    const int tid = tid_opaque(), wid = __builtin_amdgcn_readfirstlane(tid >> 6), lane = tid & 63, r = lane & 31, hh = lane >> 5;
    unsigned char* ws = p.ws;
    const float* PAC = (const float*)(ws + R_PAC);
    LAS bf16_t* ACT = (LAS bf16_t*)lds;
    LAS float* RKV = (LAS float*)(lds + 25088);
    LAS float* RED = (LAS float*)(lds + 25088 + 98304);
    const int b = item / 65, t0 = (item % 65) * 32, nvalid = (L - t0) < 32 ? (L - t0) : 32;
    const float* mu = p.rw_shift + (size_t)layer * 2 * A_TOT;
#pragma unroll 1
    for (int it0 = 0; it0 < 18; it0 += 3) {
        f32x4 pc[3], pv[3], nx[3], m0[3], m1[3]; int tts[3], cs_[3];
#pragma unroll
        for (int u = 0; u < 3; ++u) {
            const int idx = tid + (it0 + u) * NTHREADS, tt = idx / 288, c = (idx - tt * 288) * 4, l = t0 + tt;
            tts[u] = tt; cs_[u] = c;
            const float* row = PAC + (size_t)(b * L + l) * PACW + c;
            const bool ok = tt < nvalid;
            pc[u] = ok ? *(const f32x4*)row : (f32x4){0.f, 0.f, 0.f, 0.f};
            pv[u] = (ok && l > 0) ? *(const f32x4*)(row - PACW) : (f32x4){0.f, 0.f, 0.f, 0.f};
            nx[u] = (ok && l < L - 1) ? *(const f32x4*)(row + PACW) : (f32x4){0.f, 0.f, 0.f, 0.f};
            m0[u] = *(const f32x4*)(mu + c); m1[u] = *(const f32x4*)(mu + A_TOT + c);
        }
#pragma unroll
        for (int u = 0; u < 3; ++u) {
            const int tt = tts[u], c = cs_[u];
            f32x4 sft = pc[u] + m0[u] * (pv[u] - pc[u]) + m1[u] * (nx[u] - pc[u]);
            if (tt >= nvalid) sft = (f32x4){0.f, 0.f, 0.f, 0.f};
            if (c < 768) *(LAS f32x4*)(RKV + tt * 768 + c) = sft;
            else {
                int ac;
                if (c < 896) { ac = c - 768;
#pragma unroll
                    for (int j = 0; j < 4; ++j) { const float e2 = __expf(2.0f * sft[j]); sft[j] = 1.0f - 2.0f * rcp_(e2 + 1.0f); } }
                else if (c < 1024) ac = 128 + (c - 896);
                else { ac = 256 + (c - 1024);
#pragma unroll
                    for (int j = 0; j < 4; ++j) sft[j] = sigmoidf_(sft[j]); }
                *(LAS u32x2*)(ACT + tt * 392 + ac) = (u32x2){pack2(sft[0], sft[1]), pack2(sft[2], sft[3])};
            }
        }
    }
    __syncthreads();
    const int c = wid * 32 + r, h = wid >> 1;
    const bf16_t* lb = (const bf16_t*)(ws + WS_LORA) + (size_t)layer * 98304;
    f32x16 zf = zero16(), zb = zero16(), af = zero16(), ab = zero16(), gg = zero16();
#pragma unroll
    for (int ks = 0; ks < 4; ++ks) {
        const int ko = 16 * ks + 8 * hh;
        const LAS bf16_t* ap = ACT + r * 392 + ko;
        zf = MFMA32(*(const LAS bf16x8*)(ap), *(const bf16x8*)(lb + c * 64 + ko), zf);
        zb = MFMA32(*(const LAS bf16x8*)(ap + 64), *(const bf16x8*)(lb + 16384 + c * 64 + ko), zb);
        af = MFMA32(*(const LAS bf16x8*)(ap + 128), *(const bf16x8*)(lb + 32768 + c * 64 + ko), af);
        ab = MFMA32(*(const LAS bf16x8*)(ap + 192), *(const bf16x8*)(lb + 49152 + c * 64 + ko), ab);
    }
#pragma unroll
    for (int ks = 0; ks < 8; ++ks) { const int ko = 16 * ks + 8 * hh; gg = MFMA32(*(const LAS bf16x8*)(ACT + r * 392 + 256 + ko), *(const bf16x8*)(lb + 65536 + c * 128 + ko), gg); }
    const float w0f = p.rw_w0[(size_t)layer * 512 + c], w0b = p.rw_w0[(size_t)layer * 512 + 256 + c];
    const float a0f = p.rw_a0[(size_t)layer * 512 + c], a0b = p.rw_a0[(size_t)layer * 512 + 256 + c];
    const float kkc = p.rw_k_k[(size_t)layer * 256 + c], kac = p.rw_k_a[(size_t)layer * 256 + c], rkc = p.rw_r_k[(size_t)layer * 256 + c];
#pragma unroll
    for (int i = 0; i < 16; ++i) {
        const int tt = (i & 3) + 8 * (i >> 2) + 4 * hh;
        zf[i] = -0.6065306597126334f * sigmoidf_(w0f + zf[i]); zb[i] = -0.6065306597126334f * sigmoidf_(w0b + zb[i]);
        af[i] = sigmoidf_(a0f + af[i]); ab[i] = sigmoidf_(a0b + ab[i]);
        const float k = RKV[tt * 768 + 256 + c], rr = RKV[tt * 768 + c];
        const float kkr = k * kkc;
        const float kdsum = k * (2.0f + (af[i] + ab[i] - 2.0f) * kac);
        const float s1 = half_sum32(kkr * kkr), s2 = half_sum32(rr * kdsum * rkc);
        if (r == 0) { RED[tt * 8 + wid] = s1; RED[256 + tt * 8 + wid] = s2; }
    }
    __syncthreads();
    unsigned char* sb = ws + R_SCANIN + (size_t)(b * 4 + h) * SC_BH;
    float* BONUS = (float*)(ws + WS_BONUS); bf16_t* GATE = (bf16_t*)(ws + R_GATE);
    const int ch = c & 63;
#pragma unroll
    for (int g4 = 0; g4 < 4; ++g4) {
        const int tq0 = 8 * g4 + 4 * hh;
        if (tq0 < nvalid) {
            f32x4 lwf, lwb, kk4, kaf, kab; float rv[4], vv[4], kdf[4], kdb[4];
#pragma unroll
            for (int j = 0; j < 4; ++j) {
                const int i = 4 * g4 + j, tt = tq0 + j;
                const float k = RKV[tt * 768 + 256 + c];
                const float ss = RED[tt * 8 + wid] + RED[tt * 8 + (wid ^ 1)];
                const float kk = k * kkc / fmaxf(sqrtf(ss), 1e-12f);
                lwf[j] = zf[i]; lwb[j] = zb[i]; kk4[j] = kk; kaf[j] = kk * af[i]; kab[j] = kk * ab[i];
                rv[j] = RKV[tt * 768 + c]; vv[j] = RKV[tt * 768 + 512 + c];
                kdf[j] = k * (1.0f + (af[i] - 1.0f) * kac); kdb[j] = k * (1.0f + (ab[i] - 1.0f) * kac);
                const size_t row = (size_t)(b * L + t0 + tt);
                GATE[row * 256 + c] = f2bf(gg[i]);
                if (r == 0 && (wid & 1) == 0) BONUS[row * 4 + h] = RED[256 + tt * 8 + wid] + RED[256 + tt * 8 + wid + 1];
            }
            const size_t qi = ((size_t)((t0 + 16 + tq0) >> 2) * 64 + ch) * 4;
            *(f32x4*)(sb + 0 * SC_VF + qi * 4) = lwf; *(f32x4*)(sb + 1 * SC_VF + qi * 4) = lwb; *(f32x4*)(sb + 2 * SC_VF + qi * 4) = kk4;
            *(f32x4*)(sb + 3 * SC_VF + qi * 4) = kaf; *(f32x4*)(sb + 4 * SC_VF + qi * 4) = kab;
            unsigned char* hb = sb + 5 * SC_VF;
            *(u32x2*)(hb + 0 * SC_VH + qi * 2) = (u32x2){pack2(rv[0], rv[1]), pack2(rv[2], rv[3])};
            *(u32x2*)(hb + 1 * SC_VH + qi * 2) = (u32x2){pack2(vv[0], vv[1]), pack2(vv[2], vv[3])};
            *(u32x2*)(hb + 2 * SC_VH + qi * 2) = (u32x2){pack2(kdf[0], kdf[1]), pack2(kdf[2], kdf[3])};
            *(u32x2*)(hb + 3 * SC_VH + qi * 2) = (u32x2){pack2(kdb[0], kdb[1]), pack2(kdb[2], kdb[3])};
        }
    }
    __syncthreads();
}
__device__ __forceinline__ void prep_bc_item(const Params& p, int layer, int item, LAS unsigned char* lds) {
    const int tid = tid_opaque();
    unsigned char* ws = p.ws;
    const float* PAC = (const float*)(ws + R_PAC); const bf16_t* PB = (const bf16_t*)(ws + R_PB);
    bf16_t* QR = (bf16_t*)(ws + R_QR); bf16_t* KR = (bf16_t*)(ws + R_KR); bf16_t* VT = (bf16_t*)(ws + R_VT); float* GLAIN = (float*)(ws + R_GLAIN);
    LAS float* cs = (LAS float*)lds;
    LAS bf16_t* sv = (LAS bf16_t*)(lds + 16384);
    LAS float* adl = (LAS float*)(lds + 16384 + 65792);
    const int b = item / 33, l0 = (item % 33) * 64, nvalid = (L - l0) < 64 ? (L - l0) : 64;
    for (int idx = tid; idx < 2048; idx += NTHREADS) {
        const int tl = idx >> 5, d = idx & 31;
        const float inv = exp2f(-(float)d * (13.287712379549449f / 32.0f));
        const float ang = (float)(l0 + tl) * inv;
        const double xd = (double)ang; const double kq = rint(xd * 0.15915494309189535); const float rr = (float)(xd - kq * 6.283185307179586);
        cs[idx * 2] = __cosf(rr); cs[idx * 2 + 1] = __sinf(rr);
    }
    {
        u32x4 w8[8];
#pragma unroll
        for (int u = 0; u < 8; ++u) { const int idx = tid + u * NTHREADS, tl = idx >> 6, ch = idx & 63;
            w8[u] = (tl < nvalid) ? *(const u32x4*)(PB + (size_t)(b * L + l0 + tl) * B_TOT + 1024 + ch * 8) : (u32x4){0u, 0u, 0u, 0u}; }
#pragma unroll
        for (int u = 0; u < 8; ++u) { const int idx = tid + u * NTHREADS, tl = idx >> 6, ch = idx & 63;
            LAS unsigned* d = (LAS unsigned*)(sv + tl * 514 + ch * 8); d[0] = w8[u].x; d[1] = w8[u].y; d[2] = w8[u].z; d[3] = w8[u].w; }
    }
    {
        float a4[4];
#pragma unroll
        for (int u = 0; u < 4; ++u) { const int idx = tid + u * NTHREADS, tl = idx >> 5, r = idx & 31; a4[u] = (tl < nvalid) ? PAC[(size_t)(b * L + l0 + tl) * PACW + A_TOT + 768 + r] : 0.f; }
#pragma unroll
        for (int u = 0; u < 4; ++u) adl[tid + u * NTHREADS] = a4[u];
    }
    __syncthreads();
    const float qscale = 0.125f * 1.4426950408889634f;
#pragma unroll 1
    for (int it0 = 0; it0 < 8; it0 += 4) {
        u32x4 xa[4], xb[4];
#pragma unroll
        for (int u = 0; u < 4; ++u) {
            const int idx = tid + (it0 + u) * NTHREADS, d0 = (idx & 3) * 8, c = (idx >> 2) & 1, h = (idx >> 3) & 3, which = (idx >> 5) & 1, tl = idx >> 6;
            const bf16_t* src = PB + (size_t)(b * L + l0 + (tl < nvalid ? tl : 0)) * B_TOT + which * 512 + h * 128 + c * 64 + d0;
            xa[u] = *(const u32x4*)src; xb[u] = *(const u32x4*)(src + 32);
        }
#pragma unroll
        for (int u = 0; u < 4; ++u) {
            const int idx = tid + (it0 + u) * NTHREADS, d0 = (idx & 3) * 8, c = (idx >> 2) & 1, h = (idx >> 3) & 3, which = (idx >> 5) & 1, tl = idx >> 6;
            {
                const float sc = (tl < nvalid) ? (which ? 1.0f : qscale) : 0.f;
                const unsigned wa[4] = {xa[u].x, xa[u].y, xa[u].z, xa[u].w}, wb[4] = {xb[u].x, xb[u].y, xb[u].z, xb[u].w};
                unsigned oa[4], ob[4];
#pragma unroll
                for (int j = 0; j < 4; ++j) {
                    const float x1l = __uint_as_float(wa[j] << 16), x1h = __uint_as_float(wa[j] & 0xffff0000u), x2l = __uint_as_float(wb[j] << 16), x2h = __uint_as_float(wb[j] & 0xffff0000u);
                    const f32x4 cs4 = *(const LAS f32x4*)(cs + (tl * 32 + d0 + 2 * j) * 2);
                    oa[j] = pack2((x1l * cs4[0] - x2l * cs4[1]) * sc, (x1h * cs4[2] - x2h * cs4[3]) * sc);
                    ob[j] = pack2((x2l * cs4[0] + x1l * cs4[1]) * sc, (x2h * cs4[2] + x1h * cs4[3]) * sc);
                }
                bf16_t* dst = (which ? KR : QR) + ((size_t)((b * 4 + h) * 2 + c) * LQ + l0 + tl) * 64 + d0;
                *(u32x4*)dst = (u32x4){oa[0], oa[1], oa[2], oa[3]}; *(u32x4*)(dst + 32) = (u32x4){ob[0], ob[1], ob[2], ob[3]};
            }
        }
    }
    for (int idx = tid; idx < 512 * 8; idx += NTHREADS) {
        const int hdv = idx >> 3, ch = idx & 7;
        {
            unsigned w[4];
#pragma unroll
            for (int q = 0; q < 4; ++q) w[q] = (unsigned)sv[(ch * 8 + 2 * q) * 514 + hdv] | ((unsigned)sv[(ch * 8 + 2 * q + 1) * 514 + hdv] << 16);
            *(u32x4*)(VT + ((size_t)(b * 4) * 128 + hdv) * LQ + l0 + ch * 8) = (u32x4){w[0], w[1], w[2], w[3]};
        }
    }
    const float* gup = p.gl_gate_up + (size_t)layer * 2 * 16 * 128; const float* gb = p.gl_gate_b + (size_t)layer * 2 * 128;
    float laf[16], lab_[16], kx[16];
    float gw0[16], gw1[16];
    { const int cc = tid & 127;
#pragma unroll
      for (int r = 0; r < 16; ++r) { gw0[r] = gup[r * 128 + cc]; gw1[r] = gup[(16 + r) * 128 + cc]; } }
    const float gb0 = gb[tid & 127], gb1 = gb[128 + (tid & 127)];
    float qv[16];
#pragma unroll
    for (int i = 0; i < 16; ++i) { const int idx = tid + i * NTHREADS, tl = idx >> 7, cc = idx & 127; const size_t row = (size_t)(b * L + l0 + (tl < nvalid ? tl : 0));
        kx[i] = PAC[row * PACW + A_TOT + 128 + cc]; qv[i] = PAC[row * PACW + A_TOT + cc]; }
#pragma unroll
    for (int i = 0; i < 16; ++i) {
        const int idx = tid + i * NTHREADS, tl = idx >> 7, cc = idx & 127, h = cc >> 5, dk = cc & 31;
        laf[i] = 0.f; lab_[i] = 0.f;
        if (tl >= nvalid) kx[i] = 0.f;
        if (tl < nvalid) {
            const int l = l0 + tl;
            float z0 = gb0, z1 = gb1;
#pragma unroll
            for (int r = 0; r < 16; ++r) { z0 += adl[tl * 32 + r] * gw0[r]; z1 += adl[tl * 32 + 16 + r] * gw1[r]; }
            laf[i] = (fminf(z0, 0.f) - __logf(1.0f + __expf(-fabsf(z0)))) * 0.0625f; lab_[i] = (fminf(z1, 0.f) - __logf(1.0f + __expf(-fabsf(z1)))) * 0.0625f;
            float* o = GLAIN + ((size_t)(b * 4 + h) * L + l) * 128;
            o[dk] = qv[i] * 0.17677669529663687f;
            o[32 + dk] = kx[i]; o[64 + dk] = laf[i]; o[96 + dk] = lab_[i];
        }
    }
    __syncthreads();
    LAS float* LA = (LAS float*)lds;
    LAS float* KX = (LAS float*)(lds + 65536);
    LAS bf16_t* KET = (LAS bf16_t*)(lds + 65536);
    LAS bf16_t* VTG = (LAS bf16_t*)(lds + 102400);
#pragma unroll
    for (int i = 0; i < 16; ++i) { const int idx = tid + i * NTHREADS; LA[idx] = laf[i]; LA[8192 + idx] = lab_[i]; KX[idx] = kx[i]; }
    {
        f32x4 v8[8];
#pragma unroll
        for (int u = 0; u < 8; ++u) { const int idx = tid + u * NTHREADS, tl = idx >> 6, c4 = (idx & 63) * 4;
            v8[u] = (tl < nvalid) ? *(const f32x4*)(PAC + (size_t)(b * L + l0 + tl) * PACW + A_TOT + 256 + c4) : (f32x4){0.f, 0.f, 0.f, 0.f}; }
#pragma unroll
        for (int u = 0; u < 8; ++u) { const int idx = tid + u * NTHREADS, tl = idx >> 6, c4 = (idx & 63) * 4;
#pragma unroll
            for (int j = 0; j < 4; ++j) VTG[(c4 + j) * 72 + tl] = f2bf(v8[u][j]); }
    }
    __syncthreads();
    {
        const int colx = tid & 255, seg = tid >> 8, dir = colx >> 7, cc = colx & 127;
        LAS float* q = LA + dir * 8192 + cc;
        LAS float* SEG2 = (LAS float*)(lds + 139264);
        float run = 0.f;
        if (dir == 0) { for (int j = 0; j < 32; ++j) { const int tl = seg * 32 + j; run += q[tl * 128]; q[tl * 128] = run; } }
        else { for (int j = 31; j >= 0; --j) { const int tl = seg * 32 + j; run += q[tl * 128]; q[tl * 128] = run; } }
        SEG2[seg * 256 + colx] = run;
        __syncthreads();
        const float off = (dir == 0) ? (seg ? SEG2[colx] : 0.f) : (seg ? 0.f : SEG2[256 + colx]);
        if (off != 0.f || true) { for (int j = 0; j < 32; ++j) q[(seg * 32 + j) * 128] += off; }
    }
    __syncthreads();
    {
        float ke[32];
#pragma unroll
        for (int i = 0; i < 32; ++i) { const int idx = tid + i * NTHREADS, dir = idx >> 13, tl = (idx >> 7) & 63, cc = idx & 127;
            const LAS float* la = LA + dir * 8192 + cc;
            const float ref = dir ? la[0] : la[63 * 128];
            ke[i] = KX[tl * 128 + cc] * __expf(ref - la[tl * 128]); }
        if (tid < 256) { const int dir = tid >> 7, cc = tid & 127, h = cc >> 5, d = cc & 31; const LAS float* la = LA + dir * 8192 + cc;
            ((float*)(ws + R_GDEC))[((size_t)((b * 4 + h) * 33 + (l0 >> 6)) * 2 + dir) * 32 + d] = __expf(dir ? la[0] : la[63 * 128]); }
        __syncthreads();
#pragma unroll
        for (int i = 0; i < 32; ++i) { const int idx = tid + i * NTHREADS, dir = idx >> 13, tl = (idx >> 7) & 63, cc = idx & 127, h = cc >> 5, d = cc & 31;
            KET[((h * 2 + dir) * 32 + d) * 72 + tl] = f2bf(ke[i]); }
    }
    __syncthreads();
    {
        const int wid = __builtin_amdgcn_readfirstlane(tid >> 6), lane = tid & 63, r = lane & 31, hh = lane >> 5, h = wid >> 1, dir = wid & 1;
        const size_t ci = ((size_t)((b * 4 + h) * 33 + (l0 >> 6)) * 2 + dir);
        float* kv = (float*)(ws + R_GKV) + ci * 2048;
        bf16x8 af[4];
#pragma unroll
        for (int ks = 0; ks < 4; ++ks) af[ks] = *(const LAS bf16x8*)(KET + (wid * 32 + r) * 72 + 16 * ks + 8 * hh);
#pragma unroll
        for (int dvt = 0; dvt < 2; ++dvt) {
            f32x16 acc = zero16();
#pragma unroll
            for (int ks = 0; ks < 4; ++ks) acc = MFMA32(af[ks], *(const LAS bf16x8*)(VTG + (h * 64 + dvt * 32 + r) * 72 + 16 * ks + 8 * hh), acc);
#pragma unroll
            for (int i = 0; i < 16; ++i) kv[((i & 3) + 8 * (i >> 2) + 4 * hh) * 64 + dvt * 32 + r] = acc[i];
        }
    }
    __syncthreads();
}
__device__ __forceinline__ void phase_prep(const Params& p, int layer, LAS unsigned char* lds, int qdup = 0) {
    constexpr int NA = NB * 65, NBC = NB * 33;
    unsigned* ctr = (unsigned*)(p.ws + WS_CTL + WS_QCTR + (size_t)(layer * 8 + 0 + qdup * 4) * 64);
    for (int it = q_next(ctr, lds); it < NA + NBC; it = q_next(ctr, lds)) {
        if (it < NBC) prep_bc_item(p, layer, it, lds); else prep_a_item(p, layer, it - NBC, lds);
    }
}

__device__ __forceinline__ f32x4 rev4(const f32x4 v) { return (f32x4){v[3], v[2], v[1], v[0]}; }
__device__ __forceinline__ u32x2 rev4h(const u32x2 w) { return (u32x2){(w.y >> 16) | (w.y << 16), (w.x >> 16) | (w.x << 16)}; }
__device__ __forceinline__ bf16x8 acc_frag(const f32x16& X, const int s2, const bool neg) {
    union { bf16x8 v; unsigned u[4]; } f;
#pragma unroll
    for (int j = 0; j < 4; ++j) f.u[j] = pack2(X[8 * s2 + 2 * j], X[8 * s2 + 2 * j + 1]) ^ (neg ? 0x80008000u : 0u);
    return f.v;
}
__device__ __forceinline__ bf16x8 lds_frag_perm(const LAS bf16_t* p) {
    union { bf16x8 v; u32x2 h2[2]; } f;
    f.h2[0] = *(const LAS u32x2*)p; f.h2[1] = *(const LAS u32x2*)(p + 8);
    return f.v;
}

__device__ __forceinline__ void phase_rwkv_a(const Params& p, LAS unsigned char* lds) {
    const int tid0 = tid_opaque(), wid = __builtin_amdgcn_readfirstlane(tid0 >> 6);
    unsigned char* ws = p.ws;
    const int gw = blockIdx.x * NWAVES + wid, NGW = gridDim.x * NWAVES;
    for (int item = gw; item < 64 * RW_NCH; item += NGW) {
        int tid = tid0; asm volatile("" : "+v"(tid));
        const int lane = tid & 63, r = lane & 31, hh = lane >> 5;
        unsigned ldsoff = (unsigned)(tid >> 6) * 18432u;
        LAS bf16_t* M0 = (LAS bf16_t*)(lds + ldsoff);
        LAS float* Lm = (LAS float*)(lds + ldsoff);
        unsigned char* img = ws + WS_RWC + (size_t)item * RWC_BYTES + (size_t)(hh * 272 + r) * 2; asm volatile("" : "+v"(img));
        GAS bf16_t* imgG = (GAS bf16_t*)img; GAS bf16_t* imgP2 = (GAS bf16_t*)(img + 8704); GAS bf16_t* imgH = (GAS bf16_t*)(img + 13056); GAS bf16_t* imgB2 = (GAS bf16_t*)(img + 21248);
        __builtin_amdgcn_sched_barrier(0);
        const int combo = item / RW_NCH, n = item - combo * RW_NCH, dir = combo >> 5, bh = combo & 31;
        const unsigned char* sbase = ws + R_SCANIN + (size_t)bh * SC_BH;
        GAS bf16_t* p2row = (GAS bf16_t*)(ws + WS_RWC + (size_t)item * RWC_BYTES + 8704) + lane;
        float g = 0.f;
        unsigned pKK[16], pAG[16], pKG[16], pV[16];
#pragma unroll
        for (int h2 = 0; h2 < 2; ++h2) {
            f32x4 lw4[4], kk4[4], ka4[4]; u32x2 r2[4], kd2[4], v2[4];
#pragma unroll
            for (int qd = 0; qd < 4; ++qd) {
                const int Q = h2 * 4 + qd, gq = dir ? (519 - 8 * n - Q) : (8 * n + 4 + Q);
                const size_t qi = ((size_t)gq * 64 + lane) * 4;
                lw4[qd] = gload16f(sbase + (size_t)dir * SC_VF + qi * 4); kk4[qd] = gload16f(sbase + 2 * SC_VF + qi * 4); ka4[qd] = gload16f(sbase + (size_t)(3 + dir) * SC_VF + qi * 4);
                r2[qd] = gload8(sbase + 5 * SC_VF + qi * 2); kd2[qd] = gload8(sbase + 5 * SC_VF + (size_t)(2 + dir) * SC_VH + qi * 2);
                v2[qd] = gload8(sbase + 5 * SC_VF + SC_VH + qi * 2);
            }
            if (dir) {
#pragma unroll
                for (int qd = 0; qd < 4; ++qd) { lw4[qd] = rev4(lw4[qd]); kk4[qd] = rev4(kk4[qd]); ka4[qd] = rev4(ka4[qd]); r2[qd] = rev4h(r2[qd]); kd2[qd] = rev4h(kd2[qd]); v2[qd] = rev4h(v2[qd]); }
            }
#pragma unroll
            for (int qd = 0; qd < 4; ++qd) {
                float okk[4], oag[4], okg[4];
#pragma unroll
                for (int k = 0; k < 4; ++k) {
                    const int t = h2 * 16 + qd * 4 + k, tau = n * 32 + t; const bool valid = tau < L;
                    float lw = lw4[qd][k], kk = kk4[qd][k], ka = ka4[qd][k];
                    const unsigned rw = (k >> 1) ? r2[qd].y : r2[qd].x, kw = (k >> 1) ? kd2[qd].y : kd2[qd].x;
                    float rr = __uint_as_float((k & 1) ? (rw & 0xffff0000u) : (rw << 16)), kd = __uint_as_float((k & 1) ? (kw & 0xffff0000u) : (kw << 16));
                    if (!valid) { lw = 0.f; kk = 0.f; ka = 0.f; rr = 0.f; kd = 0.f; }
                    const float egp = __expf(g); g += lw; const float eg = __expf(g), eng = rcp_(eg);
                    const bf16_t rgb = f2bf(rr * eg);
                    okk[k] = kk * egp; okg[k] = kd * eng; oag[k] = ka * eng;
                    p2row[t * 68] = rgb;
                    M0[6912 + t * 72 + lane] = rgb;
                }
                const int pi = (h2 * 16 + qd * 4) >> 1;
                pKK[pi] = pack2(okk[0], okk[1]); pKK[pi + 1] = pack2(okk[2], okk[3]); pAG[pi] = pack2(oag[0], oag[1]); pAG[pi + 1] = pack2(oag[2], oag[3]);
                pKG[pi] = pack2(okg[0], okg[1]); pKG[pi + 1] = pack2(okg[2], okg[3]);
                const bool v0ok = n * 32 + h2 * 16 + qd * 4 < L;
                pV[pi] = v0ok ? v2[qd].x : 0u; pV[pi + 1] = v0ok ? v2[qd].y : 0u;
#pragma unroll
                for (int k = 0; k < 4; ++k) { const int t = h2 * 16 + qd * 4 + k; const unsigned wkk = pKK[pi + (k >> 1)], wkg = pKG[pi + (k >> 1)], wag = pAG[pi + (k >> 1)];
                    M0[t * 72 + lane] = (bf16_t)((k & 1) ? (wkk >> 16) : (wkk & 0xffffu)); M0[2304 + t * 72 + lane] = (bf16_t)((k & 1) ? (wkg >> 16) : (wkg & 0xffffu)); M0[4608 + t * 72 + lane] = (bf16_t)((k & 1) ? (wag >> 16) : (wag & 0xffffu)); }
            }
        }
        const float gC = g;
        asm volatile("" ::: "memory");
        __builtin_amdgcn_sched_barrier(0);
        f32x16 Xa = zero16(), Xk = zero16(), Xrk = zero16(), Xra = zero16();
#pragma unroll
        for (int ks = 0; ks < 4; ++ks) {
            const int o = r * 72 + 16 * ks + 8 * hh;
            const bf16x8 aAg = *(const LAS bf16x8*)(M0 + 4608 + o), aKg = *(const LAS bf16x8*)(M0 + 2304 + o), bKK = *(const LAS bf16x8*)(M0 + o), bRg = *(const LAS bf16x8*)(M0 + 6912 + o);
            Xa = MFMA32(aAg, bKK, Xa); Xk = MFMA32(aKg, bKK, Xk); Xrk = MFMA32(aKg, bRg, Xrk); Xra = MFMA32(aAg, bRg, Xra);
        }
#pragma unroll
        for (int i = 0; i < 16; ++i) { const int sl = (i & 3) + 8 * (i >> 2) + 4 * hh;
            const bool strict = sl < r, incl = sl <= r;
            Xa[i] = strict ? Xa[i] : 0.f; Xk[i] = strict ? Xk[i] : 0.f; Xrk[i] = incl ? Xrk[i] : 0.f; Xra[i] = incl ? Xra[i] : 0.f; }
        bf16x8 fXk[2], fXrk[2], fXraN[2];
#pragma unroll
        for (int s2 = 0; s2 < 2; ++s2) { fXk[s2] = acc_frag(Xk, s2, false); fXrk[s2] = acc_frag(Xrk, s2, false); fXraN[s2] = acc_frag(Xra, s2, true); }
        __builtin_amdgcn_sched_barrier(0);
        __builtin_amdgcn_sched_barrier(0);
        asm volatile("" ::: "memory");
#pragma unroll
        for (int i = 0; i < 16; ++i) Lm[((i & 3) + 8 * (i >> 2) + 4 * hh) * 32 + r] = Xa[i];
        __builtin_amdgcn_sched_barrier(0);
        asm volatile("" ::: "memory");
        float Tr[32];
#pragma unroll
        for (int j = 31; j >= 0; --j) {
            float acc = (r == j) ? 1.f : 0.f;
#pragma unroll
            for (int s_ = j + 1; s_ < 32; ++s_) acc -= Tr[s_] * Lm[j * 32 + s_];
            asm volatile("" : "+v"(acc) :: "memory");
            Tr[j] = acc;
        }
        __builtin_amdgcn_sched_barrier(0);
        bf16x8 aT[2];
#pragma unroll
        for (int s2 = 0; s2 < 2; ++s2) {
            union { bf16x8 v; unsigned u[4]; } f;
#pragma unroll
            for (int jj = 0; jj < 4; ++jj) {
                const int j0 = 2 * jj, j1 = 2 * jj + 1;
                const float lo = hh ? Tr[16 * s2 + 8 * (j0 >> 2) + 4 + (j0 & 3)] : Tr[16 * s2 + 8 * (j0 >> 2) + (j0 & 3)];
                const float hi = hh ? Tr[16 * s2 + 8 * (j1 >> 2) + 4 + (j1 & 3)] : Tr[16 * s2 + 8 * (j1 >> 2) + (j1 & 3)];
                f.u[jj] = pack2(lo, hi);
            }
            aT[s2] = f.v;
        }
        __builtin_amdgcn_sched_barrier(0);
        asm volatile("" ::: "memory");
        {
            const float egc2 = __expf(gC);
#pragma unroll
            for (int q4 = 0; q4 < 8; ++q4) {
                unsigned ae[2], ke[2];
#pragma unroll
                for (int u = 0; u < 2; ++u) { const unsigned wa = pAG[2 * q4 + u], wk = pKG[2 * q4 + u];
                    ae[u] = pack2(__uint_as_float(wa << 16) * egc2, __uint_as_float(wa & 0xffff0000u) * egc2); ke[u] = pack2(__uint_as_float(wk << 16) * egc2, __uint_as_float(wk & 0xffff0000u) * egc2); }
                *(LAS u32x2*)(M0 + lane * 36 + 4 * q4) = (u32x2){pKK[2 * q4], pKK[2 * q4 + 1]};
                *(LAS u32x2*)(M0 + 2304 + lane * 36 + 4 * q4) = (u32x2){ae[0], ae[1]};
                *(LAS u32x2*)(M0 + 4608 + lane * 36 + 4 * q4) = (u32x2){ke[0], ke[1]};
                *(LAS u32x2*)(M0 + 6912 + lane * 36 + 4 * q4) = (u32x2){pV[2 * q4], pV[2 * q4 + 1]};
            }
        }
        __builtin_amdgcn_sched_barrier(0);
        asm volatile("" ::: "memory");
        f32x16 P1[2];
#pragma unroll
        for (int dt = 0; dt < 2; ++dt) { P1[dt] = zero16();
#pragma unroll
            for (int s2 = 0; s2 < 2; ++s2) P1[dt] = MFMA32(aT[s2], lds_frag_perm(M0 + (dt * 32 + r) * 36 + 16 * s2 + 4 * hh), P1[dt]); }
        __builtin_amdgcn_sched_barrier(0);
        bf16x8 fP1[2][2];
#pragma unroll
        for (int dt = 0; dt < 2; ++dt)
#pragma unroll
            for (int s2 = 0; s2 < 2; ++s2) fP1[dt][s2] = acc_frag(P1[dt], s2, false);
        asm volatile("s_waitcnt vmcnt(0)" ::: "memory");
#pragma unroll
        for (int dt = 0; dt < 2; ++dt) {
            f32x16 Cc = zero16();
#pragma unroll
            for (int s2 = 0; s2 < 2; ++s2) Cc = MFMA32(fXraN[s2], fP1[dt][s2], Cc);
#pragma unroll
            for (int i = 0; i < 16; ++i) Cc[i] += bf2f(imgP2[((i & 3) + 8 * (i >> 2)) * 68 + dt * 32]);
#pragma unroll
            for (int i = 0; i < 16; ++i) imgP2[((i & 3) + 8 * (i >> 2)) * 68 + dt * 32] = f2bf(Cc[i]);
        }
        __builtin_amdgcn_sched_barrier(0);
        {
            const float egc = __expf(gC);
#pragma unroll
            for (int dtc = 0; dtc < 2; ++dtc) {
                const float egcol = __shfl(egc, dtc * 32 + r);
#pragma unroll
                for (int dt = 0; dt < 2; ++dt) {
                    f32x16 Ga = zero16();
#pragma unroll
                    for (int s2 = 0; s2 < 2; ++s2) Ga = MFMA32(lds_frag_perm(M0 + 2304 + (dt * 32 + r) * 36 + 16 * s2 + 4 * hh), fP1[dtc][s2], Ga);
#pragma unroll
                    for (int i = 0; i < 16; ++i) { const int dl = (i & 3) + 8 * (i >> 2) + 4 * hh;
                        const float dg = (dt == dtc && dl == r) ? egcol : 0.f;
                        imgG[(dt * 32 + (i & 3) + 8 * (i >> 2)) * 68 + dtc * 32] = f2bf(dg - Ga[i]); }
                }
            }
        }
        __builtin_amdgcn_sched_barrier(0);
        bf16x8 fB1[2][2];
#pragma unroll
        for (int vt = 0; vt < 2; ++vt) {
            f32x16 X1 = zero16();
#pragma unroll
            for (int s2 = 0; s2 < 2; ++s2) X1 = MFMA32(fXk[s2], lds_frag_perm(M0 + 6912 + (vt * 32 + r) * 36 + 16 * s2 + 4 * hh), X1);
            f32x16 B1 = zero16();
#pragma unroll
            for (int s2 = 0; s2 < 2; ++s2) B1 = MFMA32(aT[s2], acc_frag(X1, s2, false), B1);
#pragma unroll
            for (int s2 = 0; s2 < 2; ++s2) fB1[vt][s2] = acc_frag(B1, s2, false);
        }
        __builtin_amdgcn_sched_barrier(0);
#pragma unroll
        for (int vt = 0; vt < 2; ++vt) {
            f32x16 Ba = zero16();
#pragma unroll
            for (int s2 = 0; s2 < 2; ++s2) {
                Ba = MFMA32(fXrk[s2], lds_frag_perm(M0 + 6912 + (vt * 32 + r) * 36 + 16 * s2 + 4 * hh), Ba);
                Ba = MFMA32(fXraN[s2], fB1[vt][s2], Ba);
            }
            u32x4 w0, w1;
            w0.x = pack2(Ba[0], Ba[1]); w0.y = pack2(Ba[2], Ba[3]); w0.z = pack2(Ba[4], Ba[5]); w0.w = pack2(Ba[6], Ba[7]);
            w1.x = pack2(Ba[8], Ba[9]); w1.y = pack2(Ba[10], Ba[11]); w1.z = pack2(Ba[12], Ba[13]); w1.w = pack2(Ba[14], Ba[15]);
            GAS u32x4* d = (GAS u32x4*)(imgB2 - (hh * 272 + r) + (vt * 64 + lane) * 16); d[0] = w0; d[1] = w1;
        }
        __builtin_amdgcn_sched_barrier(0);
#pragma unroll
        for (int dt = 0; dt < 2; ++dt)
#pragma unroll
            for (int vt = 0; vt < 2; ++vt) {
                f32x16 Ha = zero16();
#pragma unroll
                for (int s2 = 0; s2 < 2; ++s2) {
                    Ha = MFMA32(lds_frag_perm(M0 + 4608 + (dt * 32 + r) * 36 + 16 * s2 + 4 * hh), lds_frag_perm(M0 + 6912 + (vt * 32 + r) * 36 + 16 * s2 + 4 * hh), Ha);
                    const bf16x8 ae = lds_frag_perm(M0 + 2304 + (dt * 32 + r) * 36 + 16 * s2 + 4 * hh);
                    union { bf16x8 v; unsigned u[4]; } na; na.v = ae; na.u[0] ^= 0x80008000u; na.u[1] ^= 0x80008000u; na.u[2] ^= 0x80008000u; na.u[3] ^= 0x80008000u;
                    Ha = MFMA32(na.v, fB1[vt][s2], Ha);
                }
                u32x4 w0, w1;
                w0.x = pack2(Ha[0], Ha[1]); w0.y = pack2(Ha[2], Ha[3]); w0.z = pack2(Ha[4], Ha[5]); w0.w = pack2(Ha[6], Ha[7]);
                w1.x = pack2(Ha[8], Ha[9]); w1.y = pack2(Ha[10], Ha[11]); w1.z = pack2(Ha[12], Ha[13]); w1.w = pack2(Ha[14], Ha[15]);
                GAS u32x4* d = (GAS u32x4*)(imgH - (hh * 272 + r) + ((dt * 2 + vt) * 64 + lane) * 16); d[0] = w0; d[1] = w1;
            }
        asm volatile("" ::: "memory");
    }
    __syncthreads();
}

__device__ __forceinline__ void rwkv_b_item(const Params& p, int combo, LAS unsigned char* lds) {
    const int tid = tid_opaque(), wid = __builtin_amdgcn_readfirstlane(tid >> 6), lane = tid & 63, r = lane & 31, hh = lane >> 5;
    unsigned char* ws = p.ws;
    float* YS2 = (float*)(ws + R_YS2);
    constexpr int GRP = 2, NGRP = (RW_NCH + GRP - 1) / GRP, GB = GRP * RWC_BYTES;
    {
        const int dir = combo >> 5, bh = combo & 31, b = bh >> 2, h = bh & 3;
        const unsigned char* src = ws + WS_RWC + (size_t)combo * RW_NCH * RWC_BYTES;
        const size_t total = (size_t)RW_NCH * RWC_BYTES;
        f32x16 Z[2]; Z[0] = zero16(); Z[1] = zero16();
        __syncthreads();
        for (int o = tid * 16; o < GB; o += NTHREADS * 16) *(LAS u32x4*)(lds + o) = *(const u32x4*)(src + o);
        __syncthreads();
        for (int gi = 0; gi < NGRP; ++gi) {
            u32x4 pre[7];
            const size_t noff = (size_t)(gi + 1) * GB;
#pragma unroll
            for (int q = 0; q < 7; ++q) { const size_t o = noff + (size_t)(q * NTHREADS + tid) * 16; pre[q] = (o + 16 <= total && (q * NTHREADS + tid) * 16 < GB) ? *(const u32x4*)(src + o) : (u32x4){0u, 0u, 0u, 0u}; }
            if (wid < 2) {
                const int vt = wid;
#pragma unroll 1
                for (int c = 0; c < GRP; ++c) {
                    const int n = gi * GRP + c;
                    if (n < RW_NCH) {
                        const LAS unsigned char* img = lds + (gi & 1) * GB + c * RWC_BYTES;
                        const LAS bf16_t* iG = (const LAS bf16_t*)img; const LAS bf16_t* iP2 = (const LAS bf16_t*)(img + 8704);
                        const LAS bf16_t* iH = (const LAS bf16_t*)(img + 13056); const LAS bf16_t* iB2 = (const LAS bf16_t*)(img + 21248);
                        bf16x8 zb[2][2];
#pragma unroll
                        for (int dt = 0; dt < 2; ++dt)
#pragma unroll
                            for (int s2 = 0; s2 < 2; ++s2) zb[dt][s2] = acc_frag(Z[dt], s2, false);
                        f32x16 Y;
                        { const LAS u32x4* bp = (const LAS u32x4*)(iB2 + (vt * 64 + lane) * 16); const u32x4 w0 = bp[0], w1 = bp[1];
                          const unsigned ww[8] = {w0.x, w0.y, w0.z, w0.w, w1.x, w1.y, w1.z, w1.w};
#pragma unroll
                          for (int j = 0; j < 8; ++j) { Y[2 * j] = __uint_as_float(ww[j] << 16); Y[2 * j + 1] = __uint_as_float(ww[j] & 0xffff0000u); } }
#pragma unroll
                        for (int dt = 0; dt < 2; ++dt)
#pragma unroll
                            for (int s2 = 0; s2 < 2; ++s2) Y = MFMA32(lds_frag_perm(iP2 + r * 68 + dt * 32 + 16 * s2 + 4 * hh), zb[dt][s2], Y);
#pragma unroll
                        for (int i = 0; i < 16; ++i) { const int tau = n * 32 + (i & 3) + 8 * (i >> 2) + 4 * hh;
                            if (tau < L) { const int l = dir ? (L - 1 - tau) : tau; YS2[((size_t)dir * BL + (size_t)b * L + l) * 256 + h * 64 + vt * 32 + r] = Y[i]; } }
                        f32x16 Zn[2];
#pragma unroll
                        for (int dt = 0; dt < 2; ++dt) {
                            { const LAS u32x4* hp = (const LAS u32x4*)(iH + ((dt * 2 + vt) * 64 + lane) * 16); const u32x4 w0 = hp[0], w1 = hp[1];
                              const unsigned ww[8] = {w0.x, w0.y, w0.z, w0.w, w1.x, w1.y, w1.z, w1.w};
#pragma unroll
                              for (int j = 0; j < 8; ++j) { Zn[dt][2 * j] = __uint_as_float(ww[j] << 16); Zn[dt][2 * j + 1] = __uint_as_float(ww[j] & 0xffff0000u); } }
#pragma unroll
                            for (int dc = 0; dc < 2; ++dc)
#pragma unroll
                                for (int s2 = 0; s2 < 2; ++s2) Zn[dt] = MFMA32(lds_frag_perm(iG + (dt * 32 + r) * 68 + dc * 32 + 16 * s2 + 4 * hh), zb[dc][s2], Zn[dt]);
                        }
                        Z[0] = Zn[0]; Z[1] = Zn[1];
                    }
                }
            }
            LAS unsigned char* dstb = lds + ((gi + 1) & 1) * GB;
#pragma unroll
            for (int q = 0; q < 7; ++q) { const int o = (q * NTHREADS + tid) * 16; if (o < GB) *(LAS u32x4*)(dstb + o) = pre[q]; }
            __syncthreads();
        }
    }
}

__device__ __forceinline__ void phase_gla(const Params& p, int layer, LAS unsigned char* lds) {
    const int tid = tid_opaque(), wid = __builtin_amdgcn_readfirstlane(tid >> 6), lane = tid & 63, r = lane & 31, hh = lane >> 5;
    unsigned char* ws = p.ws;
    const float* GLAIN = (const float*)(ws + R_GLAIN); const float* PAC = (const float*)(ws + R_PAC); bf16_t* MIX = (bf16_t*)(ws + WS_U);
    const float* GKV = (const float*)(ws + R_GKV); const float* GDEC = (const float*)(ws + R_GDEC);
    const float* ng = p.gl_norm_g + (size_t)layer * 64;
    LAS float* G = (LAS float*)lds;
    LAS bf16_t* ST = (LAS bf16_t*)(lds + 32768);
    LAS bf16_t* QD = (LAS bf16_t*)(lds + 43008);
    LAS bf16_t* KI = (LAS bf16_t*)(lds + 53248);
    LAS bf16_t* VTs = (LAS bf16_t*)(lds + 63488);
    LAS float* RO = (LAS float*)(lds + 72704);
    unsigned* gctr = (unsigned*)(p.ws + WS_CTL + WS_QCTR + (size_t)(layer * 8 + 3) * 64);
    for (int item = q_next(gctr, lds); item < NB * 4 * 33; item = q_next(gctr, lds)) {
        const int bh = item / 33, n = item % 33, b = bh >> 2, h = bh & 3, l0 = n * 64, nvalid = (L - l0) < 64 ? (L - l0) : 64;
        f32x4 st1[4], va = (f32x4){0.f, 0.f, 0.f, 0.f}, vb = va, gg0 = va, gg1 = va;
#pragma unroll
        for (int i = 0; i < 4; ++i) { const int idx = tid + i * NTHREADS, tl = idx >> 5, c4 = (idx & 31) * 4;
            st1[i] = (tl < nvalid) ? *(const f32x4*)(GLAIN + ((size_t)bh * L + l0 + tl) * 128 + c4) : (f32x4){0.f, 0.f, 0.f, 0.f}; }
        { const int tl = tid >> 3, dv8 = (tid & 7) * 8;
          if (tl < nvalid) { const float* vp = PAC + (size_t)(b * L + l0 + tl) * PACW + A_TOT + 256 + h * 64 + dv8; va = *(const f32x4*)vp; vb = *(const f32x4*)(vp + 4);
                             const float* gp = PAC + (size_t)(b * L + l0 + tl) * PACW + A_TOT + 512 + h * 64 + dv8; gg0 = *(const f32x4*)gp; gg1 = *(const f32x4*)(gp + 4); } }
        {
            f32x4 sf = (f32x4){0.f, 0.f, 0.f, 0.f}, sb = sf;
            const int d = tid >> 4;
            const float* kvb = GKV + (size_t)bh * 33 * 2 * 2048 + tid * 4; const float* dcb = GDEC + (size_t)bh * 33 * 2 * 32 + d;
#pragma unroll 1
            for (int m0 = 0; m0 < n; m0 += 16) {
                f32x4 kv[16]; float dc[16];
#pragma unroll
                for (int u = 0; u < 16; ++u) { const int m = (m0 + u < n) ? m0 + u : 0; kv[u] = *(const f32x4*)(kvb + (size_t)(m * 2) * 2048); dc[u] = dcb[(m * 2) * 32]; }
#pragma unroll
                for (int u = 0; u < 16; ++u) if (m0 + u < n) sf = sf * dc[u] + kv[u];
            }
#pragma unroll 1
            for (int m0 = 32; m0 > n; m0 -= 16) {
                f32x4 kv[16]; float dc[16];
#pragma unroll
                for (int u = 0; u < 16; ++u) { const int m = (m0 - u > n) ? m0 - u : 32; kv[u] = *(const f32x4*)(kvb + (size_t)(m * 2 + 1) * 2048); dc[u] = dcb[(m * 2 + 1) * 32]; }
#pragma unroll
                for (int u = 0; u < 16; ++u) if (m0 - u > n) sb = sb * dc[u] + kv[u];
            }
            const int dv0 = (tid & 15) * 4;
#pragma unroll
            for (int j = 0; j < 4; ++j) { ST[(dv0 + j) * 40 + d] = f2bf(sf[j]); ST[(64 + dv0 + j) * 40 + d] = f2bf(sb[j]); }
        }
#pragma unroll
        for (int i = 0; i < 4; ++i) { const int idx = tid + i * NTHREADS, tl = idx >> 5, c4 = (idx & 31) * 4; *(LAS f32x4*)(G + tl * 128 + c4) = st1[i]; }
        __syncthreads();
        {
            const int col = tid & 63, seg = tid >> 6, dir = col >> 5;
            LAS float* q = G + 64 + col;
            LAS float* SEGT = RO;
            float run = 0.f;
            if (dir == 0) { for (int j = 0; j < 8; ++j) { const int tl = seg * 8 + j; run += q[tl * 128]; q[tl * 128] = run; } }
            else { for (int j = 7; j >= 0; --j) { const int tl = seg * 8 + j; run += q[tl * 128]; q[tl * 128] = run; } }
            SEGT[seg * 64 + col] = run;
            __syncthreads();
            float off = 0.f;
            if (dir == 0) { for (int s_ = 0; s_ < seg; ++s_) off += SEGT[s_ * 64 + col]; }
            else { for (int s_ = 7; s_ > seg; --s_) off += SEGT[s_ * 64 + col]; }
#pragma unroll
            for (int j = 0; j < 8; ++j) q[(seg * 8 + j) * 128] += off;
        }
        __syncthreads();
        {
            const int tl = tid >> 3, d4 = (tid & 7) * 4;
            const f32x4 q4 = *(const LAS f32x4*)(G + tl * 128 + d4), k4 = *(const LAS f32x4*)(G + tl * 128 + 32 + d4);
            const f32x4 bf = *(const LAS f32x4*)(G + tl * 128 + 64 + d4), cb = *(const LAS f32x4*)(G + tl * 128 + 96 + d4);
            float qf[4], kf[4], qb[4], kb[4];
#pragma unroll
            for (int j = 0; j < 4; ++j) { const float e0 = __expf(bf[j]), e1 = __expf(cb[j]); qf[j] = q4[j] * e0; kf[j] = k4[j] * rcp_(e0); qb[j] = q4[j] * e1; kb[j] = k4[j] * rcp_(e1); }
            *(LAS u32x2*)(QD + tl * 40 + d4) = (u32x2){pack2(qf[0], qf[1]), pack2(qf[2], qf[3])};
            *(LAS u32x2*)(QD + (64 + tl) * 40 + d4) = (u32x2){pack2(qb[0], qb[1]), pack2(qb[2], qb[3])};
            *(LAS u32x2*)(KI + tl * 40 + d4) = (u32x2){pack2(kf[0], kf[1]), pack2(kf[2], kf[3])};
            *(LAS u32x2*)(KI + (64 + tl) * 40 + d4) = (u32x2){pack2(kb[0], kb[1]), pack2(kb[2], kb[3])};
            const int dv8 = (tid & 7) * 8;
#pragma unroll
            for (int j = 0; j < 4; ++j) { VTs[(dv8 + j) * 72 + tl] = f2bf(va[j]); VTs[(dv8 + 4 + j) * 72 + tl] = f2bf(vb[j]); }
        }
        __syncthreads();
        {
            const int dir = wid >> 2, tt = (wid >> 1) & 1, dvt = wid & 1;
            f32x16 O;
#pragma unroll
            for (int i = 0; i < 16; ++i) O[i] = 0.f;
            const LAS bf16_t* qd = QD + (dir * 64 + tt * 32 + r) * 40 + 8 * hh;
#pragma unroll
            for (int st = 0; st < 2; ++st) {
                const bool use = dir ? (st >= tt) : (st <= tt);
                if (use) {
                    f32x16 X;
#pragma unroll
                    for (int i = 0; i < 16; ++i) X[i] = 0.f;
                    const LAS bf16_t* ki = KI + (dir * 64 + st * 32 + r) * 40 + 8 * hh;
#pragma unroll
                    for (int ks = 0; ks < 2; ++ks) X = __builtin_amdgcn_mfma_f32_32x32x16_bf16(*(const LAS bf16x8*)(ki + 16 * ks), *(const LAS bf16x8*)(qd + 16 * ks), X, 0, 0, 0);
                    if (st == tt) {
#pragma unroll
                        for (int i = 0; i < 16; ++i) { const int sl = (i & 3) + 8 * (i >> 2) + 4 * hh; const bool keep = dir ? (sl >= r) : (sl <= r); X[i] = keep ? X[i] : 0.f; }
                    }
#pragma unroll
                    for (int s2 = 0; s2 < 2; ++s2) {
                        union { bf16x8 v; unsigned u[4]; } pa;
#pragma unroll
                        for (int j = 0; j < 4; ++j) pa.u[j] = pack2(X[8 * s2 + 2 * j], X[8 * s2 + 2 * j + 1]);
                        union { bf16x8 v; u32x2 h2[2]; } vb;
                        const LAS bf16_t* vp = VTs + (dvt * 32 + r) * 72 + st * 32 + 16 * s2 + 4 * hh;
                        vb.h2[0] = *(const LAS u32x2*)vp; vb.h2[1] = *(const LAS u32x2*)(vp + 8);
                        O = __builtin_amdgcn_mfma_f32_32x32x16_bf16(pa.v, vb.v, O, 0, 0, 0);
                    }
                }
            }
            const LAS bf16_t* stp = ST + (dir * 64 + dvt * 32 + r) * 40 + 8 * hh;
#pragma unroll
            for (int ks = 0; ks < 2; ++ks) O = __builtin_amdgcn_mfma_f32_32x32x16_bf16(*(const LAS bf16x8*)(qd + 16 * ks), *(const LAS bf16x8*)(stp + 16 * ks), O, 0, 0, 0);
#pragma unroll
            for (int i = 0; i < 16; ++i) { const int tl = tt * 32 + (i & 3) + 8 * (i >> 2) + 4 * hh; RO[(dir * 64 + tl) * 64 + dvt * 32 + r] = O[i]; }
        }
        __syncthreads();
        {
            const int tl = tid >> 3, dv0 = (tid & 7) * 8;
            float o[8]; float ss = 0.f;
#pragma unroll
            for (int j = 0; j < 8; ++j) { o[j] = RO[tl * 64 + dv0 + j] + RO[(64 + tl) * 64 + dv0 + j]; ss += o[j] * o[j]; }
            ss += dppq1(ss); ss += dppq2(ss); ss += dpphm(ss);
            const float rs = rsqrtf(ss * (1.0f / 64.0f) + 1e-6f);
            if (tl < nvalid) {
                const size_t row = (size_t)(b * L + l0 + tl);
                const f32x4 g0 = gg0, g1 = gg1, n0 = *(const f32x4*)(ng + dv0), n1 = *(const f32x4*)(ng + dv0 + 4);
                float rr[8];
#pragma unroll
                for (int j = 0; j < 4; ++j) { rr[j] = o[j] * rs * n0[j] * (g0[j] * rcp_(1.0f + __expf(-g0[j]))); rr[4 + j] = o[4 + j] * rs * n1[j] * (g1[j] * rcp_(1.0f + __expf(-g1[j]))); }
                *(u32x4*)(MIX + row * D + 768 + h * 64 + dv0) = (u32x4){pack2(rr[0], rr[1]), pack2(rr[2], rr[3]), pack2(rr[4], rr[5]), pack2(rr[6], rr[7])};
            }
        }
        __syncthreads();
    }
}

__device__ __forceinline__ void phase_post(const Params& p, int layer) {
    const int tid = tid_opaque(), wid = tid >> 6, lane = tid & 63;
    const int gw = blockIdx.x * NWAVES + wid, NGW = gridDim.x * NWAVES;
    unsigned char* ws = p.ws;
    const float* YS2 = (const float*)(ws + R_YS2); const bf16_t* GATE = (const bf16_t*)(ws + R_GATE); const float* BONUS = (const float*)(ws + WS_BONUS);
    bf16_t* MIX = (bf16_t*)(ws + WS_U);
    const int h = lane >> 4, c = lane * 4;
    const f32x4 g4 = *(const f32x4*)(p.rw_gn_g + (size_t)layer * 256 + c), b4 = *(const f32x4*)(p.rw_gn_b + (size_t)layer * 256 + c);
    constexpr int RB = 4;
    for (int row0 = gw; row0 < BL; row0 += RB * NGW) {
        f32x4 yf[RB], yb[RB]; float vv[RB][4], bs[RB]; u32x2 gw2[RB];
#pragma unroll
        for (int u = 0; u < RB; ++u) {
            const int row = (row0 + u * NGW < BL) ? row0 + u * NGW : row0, b = row / L, l = row - b * L;
            yf[u] = *(const f32x4*)(YS2 + (size_t)row * 256 + c); yb[u] = *(const f32x4*)(YS2 + ((size_t)BL + row) * 256 + c);
            const bf16_t* vq = (const bf16_t*)(ws + R_SCANIN + (size_t)(b * 4 + h) * SC_BH + 5 * SC_VF + SC_VH) + ((size_t)((l + 16) >> 2) * 64 + (c & 63)) * 4 + ((l + 16) & 3);
            vv[u][0] = bf2f(vq[0]); vv[u][1] = bf2f(vq[4]); vv[u][2] = bf2f(vq[8]); vv[u][3] = bf2f(vq[12]);
            bs[u] = BONUS[(size_t)row * 4 + h];
            gw2[u] = *(const u32x2*)(GATE + (size_t)row * 256 + c);
        }
#pragma unroll
        for (int u = 0; u < RB; ++u) {
            const int row = row0 + u * NGW;
            if (row < BL) {
                const f32x4 o = yf[u] + yb[u];
                float sm = o[0] + o[1] + o[2] + o[3];
                sm = sum16(sm);
                const float mu = sm * (1.0f / 64.0f);
                const f32x4 dlt = o - mu;
                float q = dlt[0] * dlt[0] + dlt[1] * dlt[1] + dlt[2] * dlt[2] + dlt[3] * dlt[3];
                q = sum16(q);
                const float rstd = rsqrtf(q * (1.0f / 64.0f) + 64e-5f);
                const float gt[4] = {__uint_as_float(gw2[u].x << 16), __uint_as_float(gw2[u].x & 0xffff0000u), __uint_as_float(gw2[u].y << 16), __uint_as_float(gw2[u].y & 0xffff0000u)};
                float r[4];
#pragma unroll
                for (int j = 0; j < 4; ++j) r[j] = (dlt[j] * rstd * g4[j] + b4[j] + bs[u] * vv[u][j]) * gt[j];
                u32x2 w; w.x = pack2(r[0], r[1]); w.y = pack2(r[2], r[3]);
                *(u32x2*)(MIX + (size_t)row * D + c) = w;
            }
        }
    }
}

__device__ __forceinline__ void attn_item(const Params& p, int layer, int item, LAS unsigned char* lds) {
    const int tid = tid_opaque(), wid = __builtin_amdgcn_readfirstlane(tid >> 6), lane = tid & 63, r = lane & 31, hh = lane >> 5;
    const int qg = wid >> 1, c = wid & 1;
    unsigned char* ws = p.ws;
    const bf16_t* QR = (const bf16_t*)(ws + R_QR); const bf16_t* KR = (const bf16_t*)(ws + R_KR); const bf16_t* VT = (const bf16_t*)(ws + R_VT); bf16_t* MIX = (bf16_t*)(ws + WS_U);
    constexpr int TB = 36864;
    LAS bf16x8* Qs = (LAS bf16x8*)(lds + 3 * TB + wid * 4096);
    LAS float* X = (LAS float*)lds;
    const float* lp = p.df_lam + (size_t)layer * 256;
    const float s01 = wave_sum_all(lp[lane] * lp[64 + lane]), s23 = wave_sum_all(lp[128 + lane] * lp[192 + lane]);
    const float lam_init = layer == 0 ? 0.2f : 0.35550906759096915f;
    const float lam = __int_as_float(__builtin_amdgcn_readfirstlane(__float_as_int(__expf(s01) - __expf(s23) + lam_init)));
    const float* sg = p.df_subln_g + (size_t)layer * 128;
    {
        const int item_s = __builtin_amdgcn_readfirstlane(item);
        const int bh = item_s / 17, qb = item_s % 17, b = bh >> 2, h = bh & 3;
        const int q0 = qb * 128 + qg * 32;
#pragma unroll
        for (int ks = 0; ks < 4; ++ks) {
            bf16x8 qv = *(const bf16x8*)(QR + ((size_t)(bh * 2 + c) * LQ + (q0 + r < L ? q0 + r : 0)) * 64 + ks * 16 + hh * 8);
            if (q0 + r >= L) qv = (bf16x8){0, 0, 0, 0, 0, 0, 0, 0};
            Qs[ks * 64 + lane] = qv;
        }
        f32x16 O[4];
#pragma unroll
        for (int t = 0; t < 4; ++t)
#pragma unroll
            for (int i = 0; i < 16; ++i) O[t][i] = 0.f;
        float mrun = 0.f, lsum = 0.f;
        const int key = tid >> 3, ch = tid & 7, dvA = tid >> 3, dvB = (tid + NTHREADS) >> 3;
        const bf16_t* kp0 = KR + ((size_t)(bh * 2) * LQ + key) * 64 + ch * 8; const bf16_t* kp1 = kp0 + (size_t)LQ * 64;
        const bf16_t* vp0 = VT + ((size_t)bh * 128 + dvA) * LQ + ch * 8; const bf16_t* vp1 = VT + ((size_t)bh * 128 + dvB) * LQ + ch * 8;
        u32x4 pk0 = gload16(kp0), pk1 = gload16(kp1), pv0 = gload16(vp0), pv1 = gload16(vp1);
#define ATT_PARK(bufi) do { LAS bf16_t* Kw = (LAS bf16_t*)(lds + (bufi) * TB); LAS bf16_t* Vw = (LAS bf16_t*)(lds + (bufi) * TB + 18432); \
            *(LAS u32x4*)(Kw + key * 72 + ch * 8) = pk0; *(LAS u32x4*)(Kw + (64 + key) * 72 + ch * 8) = pk1; \
            const int vo_ = (ch >> 1) * 16 + (ch & 1) * 4;     \
            *(LAS u32x2*)(Vw + dvA * 72 + vo_) = (u32x2){pv0.x, pv0.y}; *(LAS u32x2*)(Vw + dvA * 72 + vo_ + 8) = (u32x2){pv0.z, pv0.w}; \
            *(LAS u32x2*)(Vw + dvB * 72 + vo_) = (u32x2){pv1.x, pv1.y}; *(LAS u32x2*)(Vw + dvB * 72 + vo_ + 8) = (u32x2){pv1.z, pv1.w}; } while (0)
#define ATT_FETCH(t_) do { const size_t ko = (size_t)(t_) * 64 * 64, vo = (size_t)(t_) * 64; \
            pk0 = gload16(kp0 + ko); pk1 = gload16(kp1 + ko); pv0 = gload16(vp0 + vo); pv1 = gload16(vp1 + vo); } while (0)
#define ATT_QK(dst, bufi) do { const LAS bf16_t* Kq = (const LAS bf16_t*)(lds + (bufi) * TB); \
            _Pragma("unroll") for (int ks = 0; ks < 4; ++ks) { const bf16x8 bq = Qs[ks * 64 + lane]; \
                _Pragma("unroll") for (int sub = 0; sub < 2; ++sub) { const bf16x8 a_ = *(const LAS bf16x8*)(Kq + (c * 64 + sub * 32 + r) * 72 + ks * 16 + hh * 8); \
                    dst[sub] = __builtin_amdgcn_mfma_f32_32x32x16_bf16(a_, bq, ks == 0 ? negm : dst[sub], 0, 0, 0); } } \
            __builtin_amdgcn_sched_group_barrier(0x100, 4, 0); \
            _Pragma("unroll") for (int i_ = 0; i_ < 8; ++i_) { __builtin_amdgcn_sched_group_barrier(0x008, 1, 0); __builtin_amdgcn_sched_group_barrier(0x100, 1, 0); } } while (0)
        f32x16 sA[2], sB[2], negm;
#pragma unroll
        for (int i = 0; i < 16; ++i) negm[i] = 0.f;
#define SB0() __builtin_amdgcn_sched_barrier(0)
#define ATT_KF(sub, ks) (*(const LAS bf16x8*)(Kq + (c * 64 + (sub) * 32 + r) * 72 + (ks) * 16 + hh * 8))
#define ATT_VF(f) (*(const LAS bf16x8*)(Vs + (((f) & 3) * 32 + r) * 72 + ((f) >> 2) * 16 + 8 * hh))
#define ATT_EXP2(S_, sub, i0) do { S_[sub][i0] = __builtin_amdgcn_exp2f(S_[sub][i0]); S_[sub][(i0) + 1] = __builtin_amdgcn_exp2f(S_[sub][(i0) + 1]); } while (0)
#define ATT_MAXSLOT(S_, T10_, T4_, f) do { \
            if ((f) >= 8 && (f) < 13) { const int i_ = (f) - 8; T10_[i_] = max3_(S_[0][3 * i_], S_[0][3 * i_ + 1], S_[0][3 * i_ + 2]); T10_[5 + i_] = max3_(S_[1][3 * i_], S_[1][3 * i_ + 1], S_[1][3 * i_ + 2]); } \
            if ((f) == 13) { T4_[0] = max3_(T10_[0], T10_[1], T10_[2]); T4_[1] = max3_(T10_[3], T10_[4], T10_[5]); } \
            if ((f) == 14) { T4_[2] = max3_(T10_[6], T10_[7], T10_[8]); T4_[3] = max3_(T10_[9], S_[0][15], S_[1][15]); } \
            if ((f) == 15) { T4_[2] = max3_(T4_[2], T4_[3], T4_[3]); T4_[0] = max3_(T4_[0], T4_[1], T4_[2]); } } while (0)
        float mxl;
        ATT_PARK(0); ATT_FETCH(1);
        __syncthreads();
        ATT_QK(sA, 0);
        asm volatile("s_nop 15\n\ts_nop 15\n\ts_nop 15\n\ts_nop 15" : "+v"(sA[0]), "+v"(sA[1]));
        { float t10[10], t4[4];
#pragma unroll
          for (int f = 8; f < 16; ++f) ATT_MAXSLOT(sA, t10, t4, f);
          mxl = t4[0]; }
        ATT_PARK(1); ATT_FETCH(2);
        int bc = 0, bn = 1, bw = 2;
#define ATT_STEP(SC, SN, KT, DOQK, MASKN) do { \
            __syncthreads();           \
            if ((KT) < 31) ATT_PARK(bw); \
            if ((KT) < 30) ATT_FETCH((KT) + 3); \
            const LAS bf16_t* Vs = (const LAS bf16_t*)(lds + bc * TB + 18432); \
            float mx; \
            { const auto sw = __builtin_amdgcn_permlane32_swap(__float_as_uint(mxl), __float_as_uint(mxl), false, false);        \
              mx = max3_(__uint_as_float(sw[0]), __uint_as_float(sw[1]), __uint_as_float(sw[1])); } \
              \
            if ((KT) == 0 || !__all(mx <= 8.0f)) { \
                const float d_ = ((KT) == 0) ? mx : fmaxf(mx, 0.f); \
                mrun += d_; \
                if ((KT) != 0) { \
                    const float alpha = __builtin_amdgcn_exp2f(-d_); \
                    lsum *= alpha; \
                    _Pragma("unroll") for (int t = 0; t < 4; ++t) \
                        _Pragma("unroll") for (int i = 0; i < 16; ++i) O[t][i] *= alpha; \
                } \
                _Pragma("unroll") for (int sub = 0; sub < 2; ++sub) \
                    _Pragma("unroll") for (int i = 0; i < 16; ++i) SC[sub][i] -= d_; \
                _Pragma("unroll") for (int i = 0; i < 16; ++i) negm[i] = -mrun; \
            } \
              \
              \
            bf16x8 vr[4]; \
            if (DOQK) { \
                const LAS bf16_t* Kq = (const LAS bf16_t*)(lds + bn * TB); \
                f32x16 c0 = negm, c1 = negm; \
                if (MASKN) { _Pragma("unroll") for (int i = 0; i < 16; ++i) { c1[i] = -1e30f; if (i >= 8) c0[i] = -1e30f; } }        \
                bf16x8 qa = Qs[lane], ka = ATT_KF(0, 0), kb = ATT_KF(1, 0), qb = Qs[64 + lane]; \
                ATT_EXP2(SC, 0, 0); SB0(); \
                SN[0] = __builtin_amdgcn_mfma_f32_32x32x16_bf16(ka, qa, c0, 0, 0, 0);    ka = ATT_KF(0, 1); ATT_EXP2(SC, 0, 2); SB0(); \
                SN[1] = __builtin_amdgcn_mfma_f32_32x32x16_bf16(kb, qa, c1, 0, 0, 0);    kb = ATT_KF(1, 1); ATT_EXP2(SC, 0, 4); SB0(); \
                SN[0] = __builtin_amdgcn_mfma_f32_32x32x16_bf16(ka, qb, SN[0], 0, 0, 0); qa = Qs[128 + lane]; ka = ATT_KF(0, 2); ATT_EXP2(SC, 0, 6); SB0(); \
                SN[1] = __builtin_amdgcn_mfma_f32_32x32x16_bf16(kb, qb, SN[1], 0, 0, 0); kb = ATT_KF(1, 2); ATT_EXP2(SC, 0, 8); SB0(); \
                SN[0] = __builtin_amdgcn_mfma_f32_32x32x16_bf16(ka, qa, SN[0], 0, 0, 0); qb = Qs[192 + lane]; ka = ATT_KF(0, 3); ATT_EXP2(SC, 0, 10); SB0(); \
                SN[1] = __builtin_amdgcn_mfma_f32_32x32x16_bf16(kb, qa, SN[1], 0, 0, 0); kb = ATT_KF(1, 3); ATT_EXP2(SC, 0, 12); SB0(); \
                SN[0] = __builtin_amdgcn_mfma_f32_32x32x16_bf16(ka, qb, SN[0], 0, 0, 0); vr[0] = ATT_VF(0); ATT_EXP2(SC, 0, 14); SB0(); \
                SN[1] = __builtin_amdgcn_mfma_f32_32x32x16_bf16(kb, qb, SN[1], 0, 0, 0); vr[1] = ATT_VF(1); vr[2] = ATT_VF(2); SB0(); \
            } else { \
                _Pragma("unroll") for (int q2 = 0; q2 < 8; ++q2) ATT_EXP2(SC, 0, 2 * q2); \
                vr[0] = ATT_VF(0); vr[1] = ATT_VF(1); vr[2] = ATT_VF(2); SB0(); \
            } \
            { float a16[16], a8[8], t10[10], t4[4]; \
              union { bf16x8 v; unsigned u[4]; } pb; \
              _Pragma("unroll") for (int f = 0; f < 16; ++f) { \
                  const int st = f >> 2, t = f & 3, sub = st >> 1, s2 = st & 1; \
                  if (f < 8) ATT_EXP2(SC, 1, 2 * f); \
                  if (t == 0) { _Pragma("unroll") for (int j = 0; j < 4; ++j) pb.u[j] = pack2(SC[sub][8 * s2 + 2 * j], SC[sub][8 * s2 + 2 * j + 1]); } \
                  O[t] = __builtin_amdgcn_mfma_f32_32x32x16_bf16(vr[f & 3], pb.v, O[t], 0, 0, 0); \
                  if (f + 3 < 16) vr[(f + 3) & 3] = ATT_VF(f + 3); \
                  a16[f] = SC[0][f] + SC[1][f]; \
                  if (f >= 8) a8[f - 8] = a16[f - 8] + a16[f]; \
                  if (DOQK) ATT_MAXSLOT(SN, t10, t4, f); \
                  SB0(); \
              } \
              if (DOQK) mxl = t4[0]; \
              lsum += ((a8[0] + a8[4]) + (a8[1] + a8[5])) + ((a8[2] + a8[6]) + (a8[3] + a8[7])); } \
            { const int t_ = bc; bc = bn; bn = bw; bw = t_; } } while (0)
#pragma unroll 1
        for (int kt = 0; kt < 30; kt += 2) { ATT_STEP(sA, sB, kt, true, false); ATT_STEP(sB, sA, kt + 1, true, false); }
        ATT_STEP(sA, sB, 30, true, false); ATT_STEP(sB, sA, 31, true, true);
        ATT_STEP(sA, sB, 32, false, false);
#undef ATT_STEP
#undef ATT_MAXSLOT
#undef ATT_EXP2
#undef ATT_VF
#undef ATT_KF
        const float lt = lsum + __shfl_xor(lsum, 32);
        const float inv = (c ? lam : 1.0f) / lt;
        __syncthreads();
        if (c == 1) {
#pragma unroll
            for (int t = 0; t < 4; ++t)
#pragma unroll
                for (int i = 0; i < 16; ++i) { const int dv = t * 32 + (i & 3) + 8 * (i >> 2) + 4 * hh; X[(qg * 128 + dv) * 32 + r] = O[t][i] * inv; }
        }
        __syncthreads();
        if (c == 0) {
            float ss = 0.f;
#pragma unroll
            for (int t = 0; t < 4; ++t)
#pragma unroll
                for (int i = 0; i < 16; ++i) { const int dv = t * 32 + (i & 3) + 8 * (i >> 2) + 4 * hh; const float o = O[t][i] * inv - X[(qg * 128 + dv) * 32 + r]; O[t][i] = o; ss += o * o; }
            ss += __shfl_xor(ss, 32);
            const float rn = rsqrtf(ss * (1.0f / 128.0f) + 1e-6f) * (1.0f - lam_init);
            const int q = q0 + r;
            if (q < L) {
                bf16_t* dst = MIX + (size_t)(b * L + q) * D + 256 + h * 128;
#pragma unroll
                for (int t = 0; t < 4; ++t)
#pragma unroll
                    for (int g = 0; g < 4; ++g) {
                        const int dv0 = t * 32 + 8 * g + 4 * hh;
                        const f32x4 g4 = *(const f32x4*)(sg + dv0);
                        u32x2 w; w.x = pack2(O[t][4 * g] * rn * g4[0], O[t][4 * g + 1] * rn * g4[1]); w.y = pack2(O[t][4 * g + 2] * rn * g4[2], O[t][4 * g + 3] * rn * g4[3]);
                        *(u32x2*)(dst + dv0) = w;
                    }
            }
        }
        __syncthreads();
    }
}

__device__ __forceinline__ void phase_mix(const Params& p, int layer, LAS unsigned char* lds, int qdup = 0) {
    const int x = blockIdx.x & 7;
    unsigned* ctr = (unsigned*)(p.ws + WS_CTL + WS_QCTR2 + (size_t)((layer * 2 + qdup) * 8 + x) * 64);
    unsigned* done = (unsigned*)(p.ws + WS_CTL + WS_QCTR + (size_t)(layer * 8 + 2 + qdup * 4) * 64);
    constexpr int NSB = 8, NAT = 4 * 17, NCV = CONV_NCHUNK / 8;
    for (int j = q_next(ctr, lds); j < NSB + NAT + NCV; j = q_next(ctr, lds)) {
        if (j < NSB) {
            rwkv_b_item(p, (j >> 2) * 32 + x * 4 + (j & 3), lds);
            __syncthreads();
            if (threadIdx.x == 0) __hip_atomic_fetch_add(done, 1u, __ATOMIC_RELAXED, __HIP_MEMORY_SCOPE_AGENT);
        } else if (j < NSB + NAT) { const int a_ = j - NSB; attn_item(p, layer, (x * 4 + a_ / 17) * 17 + a_ % 17, lds); }
        else {
            if (threadIdx.x == 0) { unsigned sp_ = 0; while (__hip_atomic_load(done, __ATOMIC_RELAXED, __HIP_MEMORY_SCOPE_AGENT) < 64u && ++sp_ < (1u << 24)) __builtin_amdgcn_s_sleep(8); }
            __syncthreads();
            conv_chunk(p, layer, x * NCV + (j - NSB - NAT), lds);
        }
    }
}

typedef float f32x4_t __attribute__((ext_vector_type(4)));
__device__ __forceinline__ f32x4 small_tile(const bf16_t* A, int lda, const bf16_t* Bt, int ldb, int K, int lane) {
    const bf16_t* ap = A + (size_t)(lane & 15) * lda + 8 * (lane >> 4); const bf16_t* bp = Bt + (size_t)(lane & 15) * ldb + 8 * (lane >> 4);
    f32x4 acc = (f32x4){0.f, 0.f, 0.f, 0.f};
    bf16x8 a[4], b[4], an[4], bn[4];
#pragma unroll
    for (int u = 0; u < 4; ++u) { a[u] = *(const bf16x8*)(ap + 32 * u); b[u] = *(const bf16x8*)(bp + 32 * u); }
    for (int k0 = 0; k0 < K; k0 += 128) {
        const int kn = (k0 + 128 < K) ? k0 + 128 : k0;
#pragma unroll
        for (int u = 0; u < 4; ++u) { an[u] = *(const bf16x8*)(ap + kn + 32 * u); bn[u] = *(const bf16x8*)(bp + kn + 32 * u); }
#pragma unroll
        for (int u = 0; u < 4; ++u) acc = __builtin_amdgcn_mfma_f32_16x16x32_bf16(a[u], b[u], acc, 0, 0, 0);
#pragma unroll
        for (int u = 0; u < 4; ++u) { a[u] = an[u]; b[u] = bn[u]; }
    }
    return acc;
}
__device__ __forceinline__ void small_outproj(const Params& p, int layer) {
    const int tid = tid_opaque(), wid = tid >> 6, lane = tid & 63;
    unsigned char* ws = p.ws;
    const bf16_t* MIX = (const bf16_t*)(ws + WS_U); const bf16_t* W = (const bf16_t*)(ws + WS_WOUT) + (size_t)layer * D * D; float* H = (float*)(ws + WS_H);
    for (int item = blockIdx.x; item < 64; item += gridDim.x) {
        const int rg = item >> 3, cg = item & 7, row0 = 16384 + rg * 16, col0 = cg * 128 + wid * 16;
        const f32x4 acc = small_tile(MIX + (size_t)row0 * D, D, W + (size_t)col0 * D, D, D, lane);
#pragma unroll
        for (int j = 0; j < 4; ++j) { float* q = H + (size_t)(row0 + 4 * (lane >> 4) + j) * D + col0 + (lane & 15); *q += acc[j]; }
    }
}
__device__ __forceinline__ void small_moe1(const Params& p) {
    const int tid = tid_opaque(), wid = tid >> 6, lane = tid & 63;
    unsigned char* ws = p.ws;
    const bf16_t* XS = (const bf16_t*)(ws + R_XS); const bf16_t* W = (const bf16_t*)(ws + WS_W13); bf16_t* HID = (bf16_t*)(ws + R_HID);
    for (int item = blockIdx.x; item < NE * 11; item += gridDim.x) {
        const int e = item / 11, ft = item - e * 11;
        const bf16_t* A = XS + ((size_t)e * EM + 2048) * D; const bf16_t* Bw = W + ((size_t)e * 2816 + ft * 256 + wid * 16) * D;
        const f32x4 a = small_tile(A, D, Bw, D, D, lane), b = small_tile(A, D, Bw + (size_t)128 * D, D, D, lane);
#pragma unroll
        for (int j = 0; j < 4; ++j) HID[((size_t)e * EM + 2048 + 4 * (lane >> 4) + j) * FF + ft * 128 + wid * 16 + (lane & 15)] = f2bf(a[j] * rcp_(1.0f + __expf(-a[j])) * b[j]);
    }
}
__device__ __forceinline__ void small_moe2(const Params& p) {
    const int tid = tid_opaque(), wid = tid >> 6, lane = tid & 63;
    unsigned char* ws = p.ws;
    const bf16_t* HID = (const bf16_t*)(ws + R_HID); const bf16_t* W = (const bf16_t*)(ws + WS_W2); bf16_t* YS = (bf16_t*)(ws + R_YS); const float* GW = (const float*)(ws + WS_GATEW);
    for (int item = blockIdx.x; item < NE * 8; item += gridDim.x) {
        const int e = item >> 3, cg = item & 7, col0 = cg * 128 + wid * 16;
        const f32x4 acc = small_tile(HID + ((size_t)e * EM + 2048) * FF, FF, W + ((size_t)e * D + col0) * FF, FF, FF, lane);
#pragma unroll
        for (int j = 0; j < 4; ++j) { const size_t row = (size_t)e * EM + 2048 + 4 * (lane >> 4) + j; YS[row * D + col0 + (lane & 15)] = f2bf(acc[j] * GW[row]); }
    }
}

#define XB_TMO      128
#define XB_XCNT(j)  (256  + 64 * (j))
#define XB_XSUB(j)  (1280 + 64 * (j))
#define XB_XGEN(j)  (2304 + 64 * (j))
#define XB_TOP      3328
#define XB_TOPGEN   3392
#define XCD_BAR_WORDS 3456
#define XB_SPIN_CAP (1u << 22)
__device__ __forceinline__ unsigned xb_ld(unsigned* p)              { return __hip_atomic_load(p, __ATOMIC_RELAXED, __HIP_MEMORY_SCOPE_AGENT); }
__device__ __forceinline__ unsigned xb_add(unsigned* p, unsigned v) { return __hip_atomic_fetch_add(p, v, __ATOMIC_RELAXED, __HIP_MEMORY_SCOPE_AGENT); }
__device__ __forceinline__ unsigned xb_xcc_id() { return (unsigned)__builtin_amdgcn_s_getreg((3 << 11) | 20) & 0xFu; }
#define XB_SPIN(cond, bar) do { unsigned _sp = 0; while (cond) { __builtin_amdgcn_s_sleep(1); \
    if ((++_sp & 255u) == 0u) { if (xb_ld(&(bar)[XB_TMO])) break; if (_sp > XB_SPIN_CAP) { atomicAdd(&(bar)[XB_TMO], 1u); break; } } } } while (0)
struct XcdBarrier { unsigned* bar; unsigned x; volatile LAS unsigned* st; };
__device__ __forceinline__ XcdBarrier xcd_barrier_post(unsigned* bar, volatile LAS unsigned* st) {
    XcdBarrier b; b.bar = bar; b.x = xb_xcc_id(); b.st = st;
    if (threadIdx.x == 0) (void)xb_add(&bar[XB_XCNT(b.x)], 1u);
    return b;
}
__device__ __forceinline__ void xcd_barrier_complete(unsigned* bar, unsigned x, unsigned& nloc, unsigned& nx) {
    const unsigned G = gridDim.x * gridDim.y * gridDim.z;
    unsigned sum, cnt, mine, sp = 0u;
    for (;;) {
        sum = 0u; cnt = 0u; mine = 0u;
#pragma unroll
        for (unsigned j = 0; j < 16; ++j) { const unsigned c = xb_ld(&bar[XB_XCNT(j)]); sum += c; cnt += (c > 0u) ? 1u : 0u; mine = (j == x) ? c : mine; }
        if (sum == G) break;
        __builtin_amdgcn_s_sleep(1);
        if ((++sp & 255u) == 0u) { if (xb_ld(&bar[XB_TMO])) break; if (sp > XB_SPIN_CAP) { atomicAdd(&bar[XB_TMO], 1u); break; } }
    }
    nloc = mine > 0u ? mine : 1u; nx = cnt > 0u ? cnt : 1u;
}
__device__ __forceinline__ void xcd_barrier(const XcdBarrier& b) {
    asm volatile("s_waitcnt vmcnt(0)" ::: "memory");
    __syncthreads();
    if (threadIdx.x == 0) {
        unsigned* bar = b.bar;
        __builtin_amdgcn_s_waitcnt(0);
        unsigned nloc = b.st[0], nx = b.st[1];
        if (nloc == 0u) { xcd_barrier_complete(bar, b.x, nloc, nx); b.st[0] = nloc; b.st[1] = nx; }
        const unsigned old = xb_add(&bar[XB_XSUB(b.x)], 1u);
        const unsigned gen = old / nloc;
        if (old + 1u == (gen + 1u) * nloc) {
            __builtin_amdgcn_fence(__ATOMIC_RELEASE, "agent");
            asm volatile("s_waitcnt vmcnt(0)" ::: "memory");
            const unsigned og = xb_add(&bar[XB_TOP], 1u);
            const unsigned tg = og / nx;
            if (og + 1u == (tg + 1u) * nx) xb_add(&bar[XB_TOPGEN], 1u);
            else XB_SPIN(xb_ld(&bar[XB_TOPGEN]) == tg, bar);
            __builtin_amdgcn_fence(__ATOMIC_ACQUIRE, "agent");
            xb_add(&bar[XB_XGEN(b.x)], 1u);
            asm volatile("s_waitcnt vmcnt(0)" ::: "memory");
        } else {
            XB_SPIN(xb_ld(&bar[XB_XGEN(b.x)]) == gen, bar);
            __builtin_amdgcn_fence(__ATOMIC_ACQUIRE, "agent");
            asm volatile("s_waitcnt vmcnt(0)" ::: "memory");
        }
    }
    __syncthreads();
}

constexpr int PH_PER_LAYER = 15, N_PHASES = 2 * PH_PER_LAYER + 1;
#ifndef DUP_PHASE
#define DUP_PHASE (-1)
#endif
#define RUN(kk, call) do { call; if (DUP_PHASE == (kk)) { xcd_barrier(bar); call; } } while (0)
#define NEWPHASE() do { ws = p.ws; asm volatile("" : "+s"(ws)); q.ws = ws; } while (0)
template <int LAYER>
__device__ __forceinline__ void layer_body(const Params& p, Params& q, LAS unsigned char* lds, const XcdBarrier& bar) {
    constexpr int layer = LAYER;
    unsigned char* ws;
    if (LAYER == 0) { NEWPHASE(); RUN(0, phase_conv(q, layer, 0, lds)); }
    else xcd_barrier(bar);
    NEWPHASE(); phase_norm1(q, layer, LAYER == 0 ? 0 : 1);
    xcd_barrier(bar); NEWPHASE();
    { pg8::Gemm g{(const bf16_t*)(ws + WS_U), (const bf16_t*)(ws + WS_WIN) + (size_t)layer * INP * D, MP, INP, D};
      pg8::StaticOrder S; S.init(MP, INP, gridDim.x, blockIdx.x); EpiInproj E{(float*)(ws + R_PAC), (bf16_t*)(ws + R_PB)};
      RUN(2, pg8::gemm_phase(lds, g, S, E)); }
    xcd_barrier(bar); NEWPHASE();
    phase_prep(q, layer, lds); if (DUP_PHASE == 3) { xcd_barrier(bar); phase_prep(q, layer, lds, 1); }
    xcd_barrier(bar); NEWPHASE();
    RUN(4, phase_rwkv_a(q, lds));
    NEWPHASE();
    RUN(5, phase_gla(q, layer, lds));
    xcd_barrier(bar); NEWPHASE();
    phase_mix(q, layer, lds); if (DUP_PHASE == 6) { xcd_barrier(bar); phase_mix(q, layer, lds, 1); }
    xcd_barrier(bar); NEWPHASE();
    RUN(8, phase_post(q, layer));
    xcd_barrier(bar); NEWPHASE();
    { pg8::Gemm g{(const bf16_t*)(ws + WS_U), (const bf16_t*)(ws + WS_WOUT) + (size_t)layer * D * D, MP, D, D};
      pg8::StaticOrder S; S.init(16384, D, gridDim.x, blockIdx.x); EpiResidual E{(float*)(ws + WS_H)};
      small_outproj(q, layer);
      pg8::gemm_phase(lds, g, S, E); }
    xcd_barrier(bar); NEWPHASE();
    RUN(10, phase_norm2(q, layer, lds));
    xcd_barrier(bar); NEWPHASE();
    RUN(11, phase_topk(q, lds));
    xcd_barrier(bar); NEWPHASE();
    { pg8::Gemm g{(const bf16_t*)(ws + R_XS), (const bf16_t*)(ws + WS_W13), NE * EM, NE * 2816, D};
      pg8::GroupOrder S; S.init(NE, 8, 11, 9, 4, gridDim.x, blockIdx.x); EpiSwiglu E{(bf16_t*)(ws + R_HID)};
      small_moe1(q);
      RUN(13, pg8::gemm_phase(lds, g, S, E)); }
    xcd_barrier(bar); NEWPHASE();
    { pg8::Gemm g{(const bf16_t*)(ws + R_HID), (const bf16_t*)(ws + WS_W2), NE * EM, NE * D, FF};
      pg8::GroupOrder S; S.init(NE, 8, 4, 9, 4, gridDim.x, blockIdx.x); EpiDown E{(bf16_t*)(ws + R_YS), (const float*)(ws + WS_GATEW)};
      pg8::gemm_phase(lds, g, S, E);
      small_moe2(q); }
}
__global__ void __launch_bounds__(NTHREADS, 2) fwd_kernel(Params p) {
    extern __shared__ __attribute__((aligned(16))) unsigned char lds_raw[];
    LAS unsigned char* lds = (LAS unsigned char*)lds_raw;
    Params q = p;
    volatile LAS unsigned* bst = (volatile LAS unsigned*)(lds + LDS_MAIN);
    if (threadIdx.x < 16) bst[threadIdx.x] = 0u;
    __syncthreads();
    XcdBarrier bar = xcd_barrier_post((unsigned*)(p.ws + WS_CTL), bst);
    layer_body<0>(p, q, lds, bar);
    layer_body<1>(p, q, lds, bar);
    xcd_barrier(bar);
    { unsigned char* ws; NEWPHASE(); (void)ws; phase_norm1(q, 0, 2); }
}

#ifndef N_LAUNCH_MODE
#define N_LAUNCH_MODE 1
#endif
extern "C" void kernel_launch(void* const* d_in, const int* in_sizes, int n_in, void* d_out, int out_size, void* d_ws, size_t ws_size, hipStream_t stream) {
    static int grid = 0;
    if (grid == 0) {
        if (n_in != 27 || ws_size < WS_END) { fprintf(stderr, "kernel_launch: unexpected n_in %d or ws_size %zu < %zu\n", n_in, ws_size, (size_t)WS_END); grid = -1; return; }
        int dev = 0, cus = 0, per_cu = 0;
        hipGetDevice(&dev); hipDeviceGetAttribute(&cus, hipDeviceAttributeMultiprocessorCount, dev);
        if (hipFuncSetAttribute((const void*)fwd_kernel, hipFuncAttributeMaxDynamicSharedMemorySize, LDS_BYTES) != hipSuccess) { fprintf(stderr, "kernel_launch: hipFuncSetAttribute failed\n"); grid = -1; return; }
        hipOccupancyMaxActiveBlocksPerMultiprocessor(&per_cu, (const void*)fwd_kernel, NTHREADS, LDS_BYTES);
        if (per_cu < 1) { fprintf(stderr, "kernel_launch: occupancy query says %d blocks per CU\n", per_cu); per_cu = 1; }
        (void)hipGetLastError();
        grid = cus;
    }
    if (grid < 0) return;
    if (hipMemsetAsync((char*)d_ws + WS_CTL, 0, 32768, stream) != hipSuccess) { fprintf(stderr, "kernel_launch: memset failed\n"); return; }
    Params p{};
    const float** pp = (const float**)&p;
    for (int i = 0; i < 27; ++i) pp[i] = (const float*)d_in[i];
    p.out = (float*)d_out; p.ws = (unsigned char*)d_ws;
    p.ph_lo = 0; p.ph_hi = N_PHASES;
    hipLaunchKernelGGL(fwd_kernel, dim3(grid), dim3(NTHREADS), LDS_BYTES, stream, p);
    hipError_t e = hipPeekAtLastError();
    if (e != hipSuccess) fprintf(stderr, "launch failed: %s (grid %d)\n", hipGetErrorString(e), grid);
}
```

```cpp
#include <hip/hip_runtime.h>
#include <hip/hip_cooperative_groups.h>
#include <cstdio>
namespace cg = cooperative_groups;

#define LAS __attribute__((address_space(3)))
typedef unsigned short bf16_t;
typedef short bf16x8 __attribute__((ext_vector_type(8)));
typedef short bf16x4 __attribute__((ext_vector_type(4)));
typedef float f32x4 __attribute__((ext_vector_type(4)));
typedef float f32x16 __attribute__((ext_vector_type(16)));
typedef unsigned u32x4 __attribute__((ext_vector_type(4)));
typedef unsigned u32x2 __attribute__((ext_vector_type(2)));

constexpr int D = 1024, NB = 8, SEQ = 2048, NMETA = 16, L = 2064, BL = NB * L  , MP = 16640  ;
constexpr int A_TOT = 1152, B_TOT = 1536, C_TOT = 800, INC = 3488, INP = 3584, PACW = 1952;
constexpr int NE = 16, CAP = 258, FF = 1408, EM = 2304  , ES = 2064  ;
constexpr int LQ = 2304;
constexpr int SC_NQ = 524;
constexpr size_t SC_VF = (size_t)SC_NQ * 64 * 4 * 4, SC_VH = (size_t)SC_NQ * 64 * 4 * 2, SC_BH = 5 * SC_VF + 4 * SC_VH;
constexpr int NWAVES = 8, NTHREADS = 512;
constexpr int LDS_MAIN = 147456;
constexpr int LDS_BYTES = LDS_MAIN + 64;
constexpr int RWC_BYTES = 25600, RW_NCH = 65;

constexpr size_t al256(size_t x) { return (x + 255) & ~(size_t)255; }
constexpr size_t WS_CTL = 0;
constexpr size_t WS_H = 65536;
constexpr size_t WS_U = WS_H + al256((size_t)BL * D * 4);
constexpr size_t WS_WIN = WS_U + al256((size_t)MP * D * 2);
constexpr size_t WS_WOUT = WS_WIN + al256((size_t)2 * INP * D * 2);
constexpr size_t WS_W13 = WS_WOUT + al256((size_t)2 * D * D * 2);
constexpr size_t WS_W2 = WS_W13 + al256((size_t)NE * 2816 * D * 2);
constexpr size_t WS_AFF = WS_W2 + al256((size_t)NE * D * FF * 2);
constexpr size_t WS_IDX = WS_AFF + al256((size_t)NB * NE * L * 4);
constexpr size_t WS_GATEW = WS_IDX + al256((size_t)NE * EM * 4);
constexpr size_t WS_SEL = WS_GATEW + al256((size_t)NE * EM * 4);
constexpr size_t WS_BONUS = WS_SEL + al256((size_t)BL * NE * 4);
constexpr size_t WS_R = WS_BONUS + al256((size_t)BL * 4 * 4);
constexpr size_t R_PAC = WS_R;
constexpr size_t R_PB = R_PAC + al256((size_t)BL * PACW * 4);
constexpr size_t R_QR = R_PB + al256((size_t)BL * B_TOT * 2);
constexpr size_t R_KR = R_QR + al256((size_t)NB * 4 * 2 * LQ * 64 * 2);
constexpr size_t R_VT = R_KR + al256((size_t)NB * 4 * 2 * LQ * 64 * 2);
constexpr size_t R_SCANIN = R_VT + al256((size_t)NB * 4 * 128 * LQ * 2);
constexpr size_t R_YS2 = R_SCANIN + al256((size_t)NB * 4 * SC_BH);
constexpr size_t R_GATE = R_YS2 + al256((size_t)2 * BL * 256 * 4);
constexpr size_t R_GLAIN = R_GATE + al256((size_t)BL * 256 * 2);
constexpr size_t R_GKV = R_GLAIN + al256((size_t)NB * 4 * L * 128 * 4);
constexpr size_t R_GDEC = R_GKV + al256((size_t)NB * 4 * 33 * 2 * 2048 * 4);
constexpr size_t R_END = R_GDEC + al256((size_t)NB * 4 * 33 * 2 * 32 * 4);
constexpr size_t R_XS = WS_R;
constexpr size_t R_HID = R_XS + al256((size_t)NE * EM * D * 2);
constexpr size_t R_YS = R_HID + al256((size_t)NE * EM * FF * 2);
constexpr size_t R_END2 = R_YS + al256((size_t)NE * EM * D * 2);
constexpr size_t WS_LORA = R_END > R_END2 ? R_END : R_END2;
constexpr size_t WS_END = WS_LORA + 2 * 196608;
constexpr size_t WS_RWC = WS_W13;
static_assert((size_t)64 * RW_NCH * RWC_BYTES <= WS_AFF - WS_W13, "RWKV chunk images must fit the expert-weight region");

struct Params {
    const float *x, *meta, *norm1_g, *w_in, *rw_shift, *rw_w0, *rw_w_up, *rw_a0, *rw_a_up, *rw_g_up, *rw_k_k, *rw_k_a, *rw_r_k, *rw_gn_g, *rw_gn_b,
        *df_lam, *df_subln_g, *gl_gate_up, *gl_gate_b, *gl_norm_g, *w_out, *norm2_g, *router, *e_w1, *e_w3, *e_w2, *final_g;
    float* out; unsigned char* ws; int ph_lo, ph_hi;
};

#define GAS __attribute__((address_space(1)))
__device__ __forceinline__ u32x4 gload16(const void* p) { return *(const GAS u32x4*)(const GAS void*)p; }
__device__ __forceinline__ u32x2 gload8(const void* p) { return *(const GAS u32x2*)(const GAS void*)p; }
__device__ __forceinline__ f32x4 gload16f(const void* p) { return *(const GAS f32x4*)(const GAS void*)p; }
__device__ __forceinline__ int tid_opaque() { int t = threadIdx.x; asm volatile("" : "+v"(t)); return t; }
typedef __bf16 bf2_t __attribute__((ext_vector_type(2)));
typedef float f32x2 __attribute__((ext_vector_type(2)));
__device__ __forceinline__ unsigned pack2(float lo, float hi) { const f32x2 v = {lo, hi}; return __builtin_bit_cast(unsigned, __builtin_convertvector(v, bf2_t)); }
__device__ __forceinline__ bf16_t f2bf(float f) { return (bf16_t)(pack2(f, 0.f) & 0xffffu); }
__device__ __forceinline__ float bf2f(bf16_t b) { return __uint_as_float(((unsigned)b) << 16); }
__device__ __forceinline__ float rcp_(float x) { return __builtin_amdgcn_rcpf(x); }
__device__ __forceinline__ float sigmoidf_(float x) { return rcp_(1.0f + __expf(-x)); }
__device__ __forceinline__ float wave_sum_dpp(float v) {
    v += __int_as_float(__builtin_amdgcn_update_dpp(0, __float_as_int(v), 0xB1, 0xF, 0xF, false));
    v += __int_as_float(__builtin_amdgcn_update_dpp(0, __float_as_int(v), 0x4E, 0xF, 0xF, false));
    v += __int_as_float(__builtin_amdgcn_update_dpp(0, __float_as_int(v), 0x141, 0xF, 0xF, false));
    v += __int_as_float(__builtin_amdgcn_update_dpp(0, __float_as_int(v), 0x140, 0xF, 0xF, false));
    v += __int_as_float(__builtin_amdgcn_update_dpp(0, __float_as_int(v), 0x142, 0xA, 0xF, false));
    v += __int_as_float(__builtin_amdgcn_update_dpp(0, __float_as_int(v), 0x143, 0xC, 0xF, false));
    return __int_as_float(__builtin_amdgcn_readlane(__float_as_int(v), 63));
}

__device__ __forceinline__ f32x16 zero16() { f32x16 z;
#pragma unroll
    for (int i = 0; i < 16; ++i) z[i] = 0.f;
    return z; }
#define MFMA32(a, b, c) __builtin_amdgcn_mfma_f32_32x32x16_bf16((a), (b), (c), 0, 0, 0)

constexpr size_t WS_QCTR2 = 16384;
constexpr size_t WS_QCTR = 14336;
__device__ __forceinline__ int q_next(unsigned* ctr, LAS unsigned char* lds) {
    volatile LAS int* slot = (volatile LAS int*)(lds + LDS_MAIN + 32);
    __syncthreads();
    if (threadIdx.x == 0) *slot = (int)__hip_atomic_fetch_add(ctr, 1u, __ATOMIC_RELAXED, __HIP_MEMORY_SCOPE_AGENT);
    __syncthreads();
    return __builtin_amdgcn_readfirstlane(*slot);
}
__device__ __forceinline__ float wave_sum_all(float v) { return wave_sum_dpp(v); }

__device__ __forceinline__ float dppq1(float v) { return __int_as_float(__builtin_amdgcn_update_dpp(0, __float_as_int(v), 0xB1, 0xF, 0xF, false)); }
__device__ __forceinline__ float dppq2(float v) { return __int_as_float(__builtin_amdgcn_update_dpp(0, __float_as_int(v), 0x4E, 0xF, 0xF, false)); }
__device__ __forceinline__ float dpphm(float v) { return __int_as_float(__builtin_amdgcn_update_dpp(0, __float_as_int(v), 0x141, 0xF, 0xF, false)); }
__device__ __forceinline__ float dpprm(float v) { return __int_as_float(__builtin_amdgcn_update_dpp(0, __float_as_int(v), 0x140, 0xF, 0xF, false)); }
__device__ __forceinline__ float xchg16(float v, bool up) { const auto sw = __builtin_amdgcn_permlane16_swap(__float_as_uint(v), __float_as_uint(v), false, false); return __uint_as_float(up ? sw[0] : sw[1]); }
__device__ __forceinline__ float xchg32(float v, bool up) { const auto sw = __builtin_amdgcn_permlane32_swap(__float_as_uint(v), __float_as_uint(v), false, false); return __uint_as_float(up ? sw[0] : sw[1]); }
__device__ __forceinline__ float max3_(float a, float b, float c) { float d; asm("v_max3_f32 %0, %1, %2, %3" : "=v"(d) : "v"(a), "v"(b), "v"(c)); return d; }
__device__ __forceinline__ float sum16(float v) { v += dppq1(v); v += dppq2(v); v += dpphm(v); v += dpprm(v); return v; }

namespace pg8 {
constexpr int BM = 256, BK = 64, HALF = 128, HTB = HALF * BK * 2, STAGE_BYTES = 8 * HTB, NXCD = 8, WGM = 8;
__device__ __forceinline__ int lds_byte(int r, int c) { const int st = (r >> 4) * 2 + (c >> 5), rr = r & 15, cc = c & 31, ob = rr * 64 + cc * 2; return st * 1024 + (ob ^ (((ob >> 9) & 1) << 5)); }
__device__ __forceinline__ void stage_rc(int b, int& R, int& C) { const int st = b / 1024, sb = b % 1024, swz = sb ^ (((sb >> 9) & 1) << 5); R = (st >> 1) * 16 + swz / 64; C = (st & 1) * 32 + (swz % 64) / 2; }
__device__ __forceinline__ int perm32(int rho) { const int n = rho >> 4, i = rho & 15; return 8 * (i >> 2) + 4 * n + (i & 3); }
struct Unit { int pm, pn; };
struct Gemm { const bf16_t* A; const bf16_t* Bt; int M, N, K; };
struct StaticOrder {
    int nM, nN, nwg, G, c;
    __device__ void init(int M, int N, int G_, int c_) { nM = M / BM; nN = N / BM; nwg = nM * nN; G = G_; c = c_; }
    __device__ bool next(int i, Unit& u) const {
        const long Lx = (long)i * G + c; if (Lx >= nwg) return false;
        int wgid = (int)Lx; { const int q = nwg / NXCD, r = nwg % NXCD, xcd = wgid % NXCD, off = wgid / NXCD; wgid = (xcd < r ? xcd * (q + 1) : r * (q + 1) + (xcd - r) * q) + off; }
        const int nig = WGM * nN, gid = wgid / nig, fm = gid * WGM, gsz = (nM - fm) < WGM ? (nM - fm) : WGM;
        u.pm = fm + ((wgid % nig) % gsz); u.pn = (wgid % nig) / gsz; return true;
    }
};
struct GroupOrder {
    int nm, nn, ms, mb, total, G, c, gpx, spx, slot, xcd;
    __device__ void init(int ng, int nm_, int nn_, int ms_, int mb_, int G_, int c_) { nm = nm_; nn = nn_; ms = ms_; mb = mb_; total = ng * nm_ * nn_; G = G_; c = c_;
        gpx = ((G_ & 7) == 0 && (ng & 7) == 0 && nm_ % mb_ == 0) ? ng / 8 : 0; spx = G_ / 8; slot = c_ / 8; xcd = c_ & 7; }
    __device__ bool next(int i, Unit& u) const {
        const int per = nm * nn;
        if (gpx) {
            const int idx = i * spx + slot; if (idx >= gpx * per) return false;
            const int el = idx / per, rem = idx - el * per, e = xcd * gpx + el;
            const int mg = rem / (mb * nn), r2 = rem - mg * mb * nn, n = r2 / mb, m = mg * mb + (r2 - n * mb);
            u.pm = e * ms + m; u.pn = e * nn + n; return true;
        }
        const int Lx = i * G + c; if (Lx >= total) return false;
        const int e = Lx / per, rem = Lx - e * per, n = rem / nm, m = rem - n * nm;
        u.pm = e * ms + m; u.pn = e * nn + n; return true;
    }
};

template <class Epi, class Sched, bool GATHER = false>
__device__ __forceinline__ void gemm_phase(LAS unsigned char* lds, const Gemm g, const Sched& S, const Epi& E, const int* rowidx = nullptr) {
    const int tid = tid_opaque(), wid = __builtin_amdgcn_readfirstlane(tid >> 6), lane = tid & 63, wr = wid >> 2, wc = wid & 3, fr = lane & 15, fq = lane >> 4;
    const int K = g.K, nt = K / BK;
    unsigned voffA[2], voffB[2];
#pragma unroll
    for (int i = 0; i < 2; ++i) { int R, C; stage_rc(tid * 16 + i * 8192, R, C); const int Rb = Epi::PERM ? ((R & ~31) + perm32(R & 31)) : R;
        voffA[i] = (unsigned)(R * K + C) * 2u; voffB[i] = (unsigned)(Rb * K + C) * 2u; }
    int RA_[2], CA_[2];
#pragma unroll
    for (int i = 0; i < 2; ++i) stage_rc(tid * 16 + i * 8192, RA_[i], CA_[i]);
    const size_t kstep = (size_t)(BK * 2);
    const size_t hstep = (size_t)HALF * K * 2;
    const size_t hstepA = GATHER ? 0 : hstep;
    const size_t tstep = 2 * hstep;
    const unsigned ldsw = (unsigned)wid * 1024u;
    const int aoff = lds_byte(wr * 64 + fr, fq * 8), boff = lds_byte(wc * 32 + fr, fq * 8);
#define PG8_SA(b, h) (((b) * 2 + (h)) * HTB)
#define PG8_SB(b, h) ((4 + (b) * 2 + (h)) * HTB)
#define PG8_STAGE(bufoff, gbase, voff) do { _Pragma("unroll") for (int _i = 0; _i < 2; ++_i) \
        __builtin_amdgcn_global_load_lds((const unsigned*)((const char*)(gbase) + (voff)[_i]), (LAS unsigned*)(lds + (bufoff) + ldsw + _i * 8192), 16, 0, 0); } while (0)
#define PG8_LDA(dst, b, h) do { _Pragma("unroll") for (int m = 0; m < 4; ++m) _Pragma("unroll") for (int k = 0; k < 2; ++k) dst[m][k] = *(const LAS bf16x8*)(lds + PG8_SA(b, h) + aoff + m * 2048 + k * 1024); } while (0)
#define PG8_LDB(dst, b, h) do { _Pragma("unroll") for (int n = 0; n < 2; ++n) _Pragma("unroll") for (int k = 0; k < 2; ++k) dst[n][k] = *(const LAS bf16x8*)(lds + PG8_SB(b, h) + boff + n * 2048 + k * 1024); } while (0)
#define PG8_MMA(ai, bj, At, Bt) do { __builtin_amdgcn_s_setprio(1); _Pragma("unroll") for (int m = 0; m < 4; ++m) _Pragma("unroll") for (int n = 0; n < 2; ++n) _Pragma("unroll") for (int k = 0; k < 2; ++k) \
        acc[ai][bj][m][n] = __builtin_amdgcn_mfma_f32_16x16x32_bf16(Bt[n][k], At[m][k], acc[ai][bj][m][n], 0, 0, 0); __builtin_amdgcn_s_setprio(0); } while (0)
#define PG8_WAIT_V(n) asm volatile("s_waitcnt vmcnt(" #n ")" ::: "memory")
#define PG8_WAIT_L(n) asm volatile("s_waitcnt lgkmcnt(" #n ")" ::: "memory")
#define PG8_BAR __builtin_amdgcn_s_barrier()
#define PG8_SCHED __builtin_amdgcn_sched_barrier(0)
    Unit cur, nxt; int ui = 0;
    if (!S.next(0, cur)) return;
    f32x4 acc[2][2][4][2];
#pragma unroll
    for (int a = 0; a < 2; ++a)
#pragma unroll
        for (int b = 0; b < 2; ++b)
#pragma unroll
            for (int m = 0; m < 4; ++m)
#pragma unroll
                for (int n = 0; n < 2; ++n) acc[a][b][m][n] = (f32x4){0.f, 0.f, 0.f, 0.f};
    bf16x8 At[4][2], B0[2][2], B1[2][2];
    unsigned cv0[2], cv1[2], nv0[2], nv1[2];
#define PG8_GOFF(dst0, dst1, unit) do { _Pragma("unroll") for (int _i = 0; _i < 2; ++_i) { \
        if (GATHER) { const int* ri_ = rowidx + (size_t)(unit).pm * BM + RA_[_i]; dst0[_i] = (unsigned)ri_[0] * (unsigned)(K * 2) + (unsigned)(CA_[_i] * 2); dst1[_i] = (unsigned)ri_[HALF] * (unsigned)(K * 2) + (unsigned)(CA_[_i] * 2); } \
        else { dst0[_i] = voffA[_i]; dst1[_i] = voffA[_i]; } } } while (0)
    PG8_GOFF(cv0, cv1, cur);
    const char* cA = (const char*)g.A + (GATHER ? 0 : (size_t)cur.pm * tstep); const char* cB = (const char*)g.Bt + (size_t)cur.pn * tstep;
    PG8_STAGE(PG8_SB(0, 0), cB, voffB); PG8_STAGE(PG8_SA(0, 0), cA, cv0); PG8_STAGE(PG8_SB(0, 1), cB + hstep, voffB); PG8_STAGE(PG8_SA(0, 1), cA + hstepA, cv1);
    if (wr == 1) PG8_BAR;
    PG8_WAIT_V(4); PG8_BAR;
    PG8_STAGE(PG8_SB(1, 0), cB + kstep, voffB); PG8_STAGE(PG8_SA(1, 0), cA + kstep, cv0); PG8_STAGE(PG8_SB(1, 1), cB + hstep + kstep, voffB);
    PG8_WAIT_V(6); PG8_BAR;
    for (;;) {
        const bool has_next = S.next(ui + 1, nxt);
        const char* nA = (has_next && !GATHER) ? (const char*)g.A + (size_t)nxt.pm * tstep : cA; const char* nB = has_next ? (const char*)g.Bt + (size_t)nxt.pn * tstep : cB;
        if (has_next) PG8_GOFF(nv0, nv1, nxt); else { nv0[0] = cv0[0]; nv0[1] = cv0[1]; nv1[0] = cv1[0]; nv1[1] = cv1[1]; }
        for (int t = 0; t < nt; t += 2) {
            const bool last = (t == nt - 2);
            const char* a1 = cA + (size_t)(t + 1) * kstep;
            const char* a2 = last ? nA : cA + (size_t)(t + 2) * kstep; const char* b2 = last ? nB : cB + (size_t)(t + 2) * kstep;
            const char* a3 = a2 + kstep; const char* b3 = b2 + kstep;
            unsigned x0[2], x1[2];
            x0[0] = last ? nv0[0] : cv0[0]; x0[1] = last ? nv0[1] : cv0[1]; x1[0] = last ? nv1[0] : cv1[0]; x1[1] = last ? nv1[1] : cv1[1];
            PG8_LDB(B0, 0, 0); PG8_SCHED; PG8_LDA(At, 0, 0); PG8_STAGE(PG8_SA(1, 1), a1 + hstepA, cv1);
            PG8_WAIT_L(8); PG8_BAR; PG8_WAIT_L(0); PG8_MMA(0, 0, At, B0); PG8_BAR; PG8_SCHED;
            PG8_LDB(B1, 0, 1); PG8_STAGE(PG8_SB(0, 0), b2, voffB);
            PG8_BAR; PG8_WAIT_L(0); PG8_MMA(0, 1, At, B1); PG8_BAR;
            PG8_LDA(At, 0, 1); PG8_STAGE(PG8_SA(0, 0), a2, x0);
            PG8_BAR; PG8_WAIT_L(0); PG8_MMA(1, 0, At, B0); PG8_BAR; PG8_SCHED;
            PG8_STAGE(PG8_SB(0, 1), b2 + hstep, voffB);
            PG8_WAIT_V(6); PG8_BAR; PG8_MMA(1, 1, At, B1); PG8_BAR;
            PG8_LDB(B0, 1, 0); PG8_SCHED; PG8_LDA(At, 1, 0); PG8_STAGE(PG8_SA(0, 1), a2 + hstepA, x1);
            PG8_WAIT_L(8); PG8_BAR; PG8_WAIT_L(0); PG8_MMA(0, 0, At, B0); PG8_BAR; PG8_SCHED;
            PG8_LDB(B1, 1, 1); PG8_STAGE(PG8_SB(1, 0), b3, voffB);
            PG8_BAR; PG8_WAIT_L(0); PG8_MMA(0, 1, At, B1); PG8_BAR;
            PG8_LDA(At, 1, 1); PG8_STAGE(PG8_SA(1, 0), a3, x0);
            PG8_BAR; PG8_WAIT_L(0); PG8_MMA(1, 0, At, B0); PG8_BAR; PG8_SCHED;
            PG8_STAGE(PG8_SB(1, 1), b3 + hstep, voffB);
            PG8_WAIT_V(6); PG8_BAR; PG8_MMA(1, 1, At, B1); PG8_BAR;
        }
        E(acc, cur, wr, wc, fr, fq);
        if (!has_next) break;
#pragma unroll
        for (int a = 0; a < 2; ++a)
#pragma unroll
            for (int b = 0; b < 2; ++b)
#pragma unroll
                for (int m = 0; m < 4; ++m)
#pragma unroll
                    for (int n = 0; n < 2; ++n) acc[a][b][m][n] = (f32x4){0.f, 0.f, 0.f, 0.f};
        cur = nxt; cA = nA; cB = nB; ++ui;
        cv0[0] = nv0[0]; cv0[1] = nv0[1]; cv1[0] = nv1[0]; cv1[1] = nv1[1];
    }
    PG8_WAIT_V(0);
    if (wr == 0) PG8_BAR;
    PG8_BAR;
#undef PG8_GOFF
#undef PG8_SA
#undef PG8_SB
#undef PG8_STAGE
#undef PG8_LDA
#undef PG8_LDB
#undef PG8_MMA
#undef PG8_WAIT_V
#undef PG8_WAIT_L
#undef PG8_BAR
#undef PG8_SCHED
}
}

struct EpiInproj {
    static constexpr bool PERM = false;
    float* pac; bf16_t* pb;
    __device__ __forceinline__ void operator()(const f32x4 (&acc)[2][2][4][2], const pg8::Unit& u, int wr, int wc, int fr, int fq) const {
        const int row0 = u.pm * 256 + wr * 64 + fr, col0 = u.pn * 256 + wc * 32 + 4 * fq;
#pragma unroll
        for (int ai = 0; ai < 2; ++ai)
#pragma unroll
            for (int m = 0; m < 4; ++m) {
                const int row = row0 + ai * 128 + m * 16;
                if (row < BL) {
#pragma unroll
                    for (int bj = 0; bj < 2; ++bj)
#pragma unroll
                        for (int n = 0; n < 2; ++n) {
                            const int c = col0 + bj * 128 + n * 16; const f32x4 v = acc[ai][bj][m][n];
                            if (c < A_TOT) *(f32x4*)(pac + (size_t)row * PACW + c) = v;
                            else if (c < A_TOT + B_TOT) { u32x2 w; w.x = pack2(v[0], v[1]); w.y = pack2(v[2], v[3]); *(u32x2*)(pb + (size_t)row * B_TOT + (c - A_TOT)) = w; }
                            else if (c < INC) *(f32x4*)(pac + (size_t)row * PACW + A_TOT + (c - A_TOT - B_TOT)) = v;
                        }
                }
            }
    }
};
struct EpiResidual {
    static constexpr bool PERM = false;
    float* h;
    __device__ __forceinline__ void operator()(const f32x4 (&acc)[2][2][4][2], const pg8::Unit& u, int wr, int wc, int fr, int fq) const {
        const int row0 = u.pm * 256 + wr * 64 + fr, col0 = u.pn * 256 + wc * 32 + 4 * fq;
#pragma unroll
        for (int ai = 0; ai < 2; ++ai)
#pragma unroll
            for (int m = 0; m < 4; ++m) {
                const int row = row0 + ai * 128 + m * 16;
                if (row < BL) {
#pragma unroll
                    for (int bj = 0; bj < 2; ++bj)
#pragma unroll
                        for (int n = 0; n < 2; ++n) { float* p = h + (size_t)row * D + col0 + bj * 128 + n * 16; *(f32x4*)p = *(const f32x4*)p + acc[ai][bj][m][n]; }
                }
            }
    }
};
struct EpiSwiglu {
    static constexpr bool PERM = true;
    bf16_t* hid;
    __device__ __forceinline__ void operator()(const f32x4 (&acc)[2][2][4][2], const pg8::Unit& u, int wr, int wc, int fr, int fq) const {
        const int e = u.pm / 9, pnl = u.pn - e * 11;
        const int row0 = u.pm * 256 + wr * 64 + fr, colf = pnl * 128 + wc * 32 + 8 * fq;
#pragma unroll
        for (int ai = 0; ai < 2; ++ai)
#pragma unroll
            for (int m = 0; m < 4; ++m) {
                const int row = row0 + ai * 128 + m * 16;
                float o[8];
#pragma unroll
                for (int n = 0; n < 2; ++n)
#pragma unroll
                    for (int j = 0; j < 4; ++j) { const float a = acc[ai][0][m][n][j], b = acc[ai][1][m][n][j]; o[n * 4 + j] = a * rcp_(1.0f + __expf(-a)) * b; }
                u32x4 w; w.x = pack2(o[0], o[1]); w.y = pack2(o[2], o[3]); w.z = pack2(o[4], o[5]); w.w = pack2(o[6], o[7]);
                *(u32x4*)(hid + (size_t)row * FF + colf) = w;
                asm volatile("" ::: "memory");
            }
    }
};
struct EpiDown {
    static constexpr bool PERM = true;
    bf16_t* ys; const float* gatew;
    __device__ __forceinline__ void operator()(const f32x4 (&acc)[2][2][4][2], const pg8::Unit& u, int wr, int wc, int fr, int fq) const {
        const int e = u.pm / 9, pnl = u.pn - e * 4, ml = u.pm - e * 9;
        const int rl0 = ml * 256 + wr * 64 + fr, col0 = pnl * 256 + wc * 32 + 8 * fq;
#pragma unroll
        for (int ai = 0; ai < 2; ++ai)
#pragma unroll
            for (int m = 0; m < 4; ++m) {
                const int rl = rl0 + ai * 128 + m * 16;
                if (rl < ES) {
                    const size_t row = (size_t)e * EM + rl; const float gw = gatew[row];
#pragma unroll
                    for (int bj = 0; bj < 2; ++bj) {
                        const f32x4 v0 = acc[ai][bj][m][0] * gw, v1 = acc[ai][bj][m][1] * gw;
                        u32x4 w; w.x = pack2(v0[0], v0[1]); w.y = pack2(v0[2], v0[3]); w.z = pack2(v1[0], v1[1]); w.w = pack2(v1[2], v1[3]);
                        *(u32x4*)(ys + row * D + col0 + bj * 128) = w;
                    }
                }
                asm volatile("" ::: "memory");
            }
    }
};

__device__ __forceinline__ void conv_tile(const float* __restrict__ src, int K, int N, bf16_t* __restrict__ dst, int k0, int n0, int nrow0, LAS bf16_t* sm, int lane) {
    const bool okc = n0 + lane < N;
#pragma unroll
    for (int half = 0; half < 2; ++half) {
        float v[32];
#pragma unroll
        for (int kk = 0; kk < 32; ++kk) v[kk] = okc ? __builtin_nontemporal_load(src + (size_t)(k0 + half * 32 + kk) * N + n0 + lane) : 0.f;
#pragma unroll
        for (int kk = 0; kk < 32; kk += 2) *(LAS unsigned*)(sm + lane * 68 + half * 32 + kk) = pack2(v[kk], v[kk + 1]);
    }
    asm volatile("" ::: "memory");
    const int rg = lane >> 3, ch = lane & 7;
#pragma unroll
    for (int ps = 0; ps < 8; ++ps) {
        const int row = ps * 8 + rg;
        const u32x2 a = *(const LAS u32x2*)(sm + row * 68 + ch * 8), c = *(const LAS u32x2*)(sm + row * 68 + ch * 8 + 4);
        if (n0 + row < N) *(u32x4*)(dst + (size_t)(nrow0 + row) * K + k0 + ch * 8) = (u32x4){a.x, a.y, c.x, c.y};
    }
    asm volatile("" ::: "memory");
}
__device__ __forceinline__ void conv_expert_tile(const Params& p, int layer, int r, LAS bf16_t* sm, int lane) {
    constexpr int T13 = 16 * 22, T2 = 22 * 16;
    unsigned char* ws = p.ws;
    const int e = r / (2 * T13 + T2); r -= e * (2 * T13 + T2);
    if (r < 2 * T13) {
        const int which = r / T13; r -= which * T13;
        const int kt = r / 22, ntile = r % 22, n0 = ntile * 64, k0 = kt * 64;
        const float* src = (which ? p.e_w3 : p.e_w1) + ((size_t)layer * NE + e) * (size_t)D * FF;
        bf16_t* dst = (bf16_t*)(ws + WS_W13) + (size_t)e * 2816 * D;
        conv_tile(src, D, FF, dst, k0, n0, (n0 >> 7) * 256 + (n0 & 127) + which * 128, sm, lane);
    } else {
        r -= 2 * T13;
        const int kt = r / 16, ntile = r % 16, n0 = ntile * 64, k0 = kt * 64;
        const float* src = p.e_w2 + ((size_t)layer * NE + e) * (size_t)FF * D;
        bf16_t* dst = (bf16_t*)(ws + WS_W2) + (size_t)e * D * FF;
        conv_tile(src, FF, D, dst, k0, n0, n0, sm, lane);
    }
}
constexpr int CONV_NTILES = NE * (2 * 16 * 22 + 22 * 16), CONV_CHUNK = 16, CONV_NCHUNK = CONV_NTILES / CONV_CHUNK;
__device__ __forceinline__ void conv_chunk(const Params& p, int layer, int chunk, LAS unsigned char* lds) {
    const int tid = tid_opaque(), wid = tid >> 6, lane = tid & 63;
    LAS bf16_t* sm = (LAS bf16_t*)(lds + wid * 8704);
#pragma unroll 1
    for (int q = 0; q < CONV_CHUNK / NWAVES; ++q) conv_expert_tile(p, layer, chunk * CONV_CHUNK + q * NWAVES + wid, sm, lane);
}
__device__ __forceinline__ void phase_conv(const Params& p, int layer, int what, LAS unsigned char* lds) {
    const int tid = tid_opaque(), wid = tid >> 6, lane = tid & 63;
    LAS bf16_t* sm = (LAS bf16_t*)(lds + wid * 8704);
    const int gw = blockIdx.x * NWAVES + wid, NGW = gridDim.x * NWAVES;
    unsigned char* ws = p.ws;
    constexpr int T13 = 16 * 22, T2 = 22 * 16;
    constexpr int NEXP = NE * (2 * T13 + T2);
    constexpr int TIN = 16 * 55, TOUT = 16 * 16;
    const int it0 = what ? 0 : NEXP, nit = what ? NEXP : NEXP + 2 * (TIN + TOUT) + 2 * 96 + 48;
    for (int it = it0 + gw; it < nit; it += NGW) {
        int r = it;
        if (r < NEXP) {
            const int e = r / (2 * T13 + T2); r -= e * (2 * T13 + T2);
            if (r < 2 * T13) {
                const int which = r / T13; r -= which * T13;
                const int kt = r / 22, ntile = r % 22, n0 = ntile * 64, k0 = kt * 64;
                const float* src = (which ? p.e_w3 : p.e_w1) + ((size_t)layer * NE + e) * (size_t)D * FF;
                bf16_t* dst = (bf16_t*)(ws + WS_W13) + (size_t)e * 2816 * D;
                conv_tile(src, D, FF, dst, k0, n0, (n0 >> 7) * 256 + (n0 & 127) + which * 128, sm, lane);
            } else {
                r -= 2 * T13;
                const int kt = r / 16, ntile = r % 16, n0 = ntile * 64, k0 = kt * 64;
                const float* src = p.e_w2 + ((size_t)layer * NE + e) * (size_t)FF * D;
                bf16_t* dst = (bf16_t*)(ws + WS_W2) + (size_t)e * D * FF;
                conv_tile(src, FF, D, dst, k0, n0, n0, sm, lane);
            }
            continue;
        }
        r -= NEXP;
        if (r < 2 * TIN) {
            const int ly = r / TIN; r -= ly * TIN;
            const int kt = r / 55, ntile = r % 55, n0 = ntile * 64, k0 = kt * 64;
            conv_tile(p.w_in + (size_t)ly * D * INC, D, INC, (bf16_t*)(ws + WS_WIN) + (size_t)ly * INP * D, k0, n0, n0, sm, lane);
            continue;
        }
        r -= 2 * TIN;
        if (r < 2 * TOUT) {
            const int ly = r / TOUT; r -= ly * TOUT;
            const int kt = r / 16, ntile = r % 16, n0 = ntile * 64, k0 = kt * 64;
            conv_tile(p.w_out + (size_t)ly * D * D, D, D, (bf16_t*)(ws + WS_WOUT) + (size_t)ly * D * D, k0, n0, n0, sm, lane);
            continue;
        }
        r -= 2 * TOUT;
        if (r >= 2 * 96) {
            r -= 2 * 96;
            const int ly = r / 24, q = r % 24;
            bf16_t* lb = (bf16_t*)(ws + WS_LORA) + (size_t)ly * 98304;
            if (q < 8) conv_tile(p.rw_w_up + ((size_t)ly * 2 + (q >> 2)) * 64 * 256, 64, 256, lb + (q >> 2) * 16384, 0, (q & 3) * 64, (q & 3) * 64, sm, lane);
            else if (q < 16) conv_tile(p.rw_a_up + ((size_t)ly * 2 + ((q - 8) >> 2)) * 64 * 256, 64, 256, lb + 32768 + ((q - 8) >> 2) * 16384, 0, (q & 3) * 64, (q & 3) * 64, sm, lane);
            else conv_tile(p.rw_g_up + (size_t)ly * 128 * 256, 128, 256, lb + 65536, ((q - 16) >> 2) * 64, (q & 3) * 64, (q & 3) * 64, sm, lane);
            continue;
        }
        {
            const int ly = r / 96, row = INC + r % 96;
            u32x4* d = (u32x4*)((bf16_t*)(ws + WS_WIN) + ((size_t)ly * INP + row) * D);
            d[lane] = (u32x4){0u, 0u, 0u, 0u}; d[lane + 64] = (u32x4){0u, 0u, 0u, 0u};
        }
    }
    __syncthreads();
}

__device__ __forceinline__ void phase_norm1(const Params& p, int layer, int mode) {
    const int tid = tid_opaque(), wid = tid >> 6, lane = tid & 63;
    const int gw = blockIdx.x * NWAVES + wid, NGW = gridDim.x * NWAVES;
    unsigned char* ws = p.ws;
    float* H = (float*)(ws + WS_H); bf16_t* U = (bf16_t*)(ws + WS_U);
    const int* SEL = (const int*)(ws + WS_SEL); const bf16_t* YS = (const bf16_t*)(ws + R_YS);
    const float* g = (mode == 2) ? p.final_g : p.norm1_g + (size_t)layer * D;
    const f32x4 gq[4] = {*(const f32x4*)(g + lane * 4), *(const f32x4*)(g + 256 + lane * 4), *(const f32x4*)(g + 512 + lane * 4), *(const f32x4*)(g + 768 + lane * 4)};
    f32x4 vn[4]; int sn_ = -1;
#define N1_FETCH(rw) do { const int r_ = (rw); if (r_ < BL) { const int b_ = r_ / L, l_ = r_ - b_ * L; \
        const float* src_ = (mode == 0) ? ((l_ < NMETA) ? p.meta + (size_t)l_ * D : p.x + ((size_t)b_ * SEQ + (l_ - NMETA)) * D) : H + (size_t)r_ * D; \
        _Pragma("unroll") for (int i = 0; i < 4; ++i) vn[i] = *(const f32x4*)(src_ + i * 256 + lane * 4); \
        if (mode != 0) sn_ = SEL[(size_t)r_ * NE + (lane & 15)]; } } while (0)
    N1_FETCH(gw);
    for (int row = gw; row < MP; row += NGW) {
        if (row >= BL) { if (mode != 2) { u32x2* d = (u32x2*)(U + (size_t)row * D); for (int i = 0; i < 4; ++i) d[i * 64 + lane] = (u32x2){0u, 0u}; } continue; }
        const int b = row / L, l = row - b * L;
        f32x4 v[4];
#pragma unroll
        for (int i = 0; i < 4; ++i) v[i] = vn[i];
        const int mys = sn_;
        N1_FETCH(row + NGW);
        if (mode == 2 && l < NMETA) continue;
        if (mode != 0) {
            unsigned rem = (unsigned)__ballot((lane < 16) && (mys >= 0)) & 0xffffu;
            while (rem) {
                u32x2 w[4][4];
#pragma unroll
                for (int q = 0; q < 4; ++q) {
                    if (rem) { const int e = __builtin_ctz(rem); rem &= rem - 1u; const int sl = __builtin_amdgcn_readlane(mys, e);
                        const bf16_t* yr = YS + ((size_t)e * EM + sl) * D;
#pragma unroll
                        for (int i = 0; i < 4; ++i) w[q][i] = *(const u32x2*)(yr + i * 256 + lane * 4); }
                    else {
#pragma unroll
                        for (int i = 0; i < 4; ++i) w[q][i] = (u32x2){0u, 0u}; }
                }
#pragma unroll
                for (int q = 0; q < 4; ++q)
#pragma unroll
                    for (int i = 0; i < 4; ++i) { v[i][0] += __uint_as_float(w[q][i].x << 16); v[i][1] += __uint_as_float(w[q][i].x & 0xffff0000u); v[i][2] += __uint_as_float(w[q][i].y << 16); v[i][3] += __uint_as_float(w[q][i].y & 0xffff0000u); }
            }
        }
        if (mode != 2) {
#pragma unroll
            for (int i = 0; i < 4; ++i) *(f32x4*)(H + (size_t)row * D + i * 256 + lane * 4) = v[i];
        }
        float ss = 0.f;
#pragma unroll
        for (int i = 0; i < 4; ++i) ss += v[i][0] * v[i][0] + v[i][1] * v[i][1] + v[i][2] * v[i][2] + v[i][3] * v[i][3];
        ss = wave_sum_all(ss);
        const float rs = rsqrtf(ss * (1.0f / D) + 1e-6f);
#pragma unroll
        for (int i = 0; i < 4; ++i) {
            const f32x4 o = v[i] * rs * gq[i];
            if (mode == 2) *(f32x4*)(p.out + ((size_t)b * SEQ + (l - NMETA)) * D + i * 256 + lane * 4) = o;
            else { u32x2 w; w.x = pack2(o[0], o[1]); w.y = pack2(o[2], o[3]); *(u32x2*)(U + (size_t)row * D + i * 256 + lane * 4) = w; }
        }
    }
#undef N1_FETCH
}

__device__ __forceinline__ void phase_norm2(const Params& p, int layer, LAS unsigned char* lds) {
    const int tid = tid_opaque(), wid = tid >> 6, lane = tid & 63;
    const int gw = blockIdx.x * NWAVES + wid, NGW = gridDim.x * NWAVES;
    unsigned char* ws = p.ws;
    const float* H = (const float*)(ws + WS_H); bf16_t* U = (bf16_t*)(ws + WS_U); float* AFF = (float*)(ws + WS_AFF);
    const float* g = p.norm2_g + (size_t)layer * D; const float* rt = p.router + (size_t)layer * D * NE;
    LAS float* RT = (LAS float*)lds;
    for (int idx = tid; idx < D * NE / 4; idx += NTHREADS) {
        const f32x4 w = *(const f32x4*)(rt + idx * 4); const int col = idx >> 2, e0 = (idx & 3) * 4;
        RT[(e0 + 0) * D + col] = w[0]; RT[(e0 + 1) * D + col] = w[1]; RT[(e0 + 2) * D + col] = w[2]; RT[(e0 + 3) * D + col] = w[3];
    }
    __syncthreads();
    const f32x4 gq[4] = {*(const f32x4*)(g + lane * 4), *(const f32x4*)(g + 256 + lane * 4), *(const f32x4*)(g + 512 + lane * 4), *(const f32x4*)(g + 768 + lane * 4)};
    f32x4 vn[4];
#pragma unroll
    for (int i = 0; i < 4; ++i) vn[i] = (gw < BL) ? *(const f32x4*)(H + (size_t)gw * D + i * 256 + lane * 4) : (f32x4){0.f, 0.f, 0.f, 0.f};
    for (int row = gw; row < BL; row += NGW) {
        const int b = row / L, l = row - b * L;
        f32x4 v[4];
#pragma unroll
        for (int i = 0; i < 4; ++i) v[i] = vn[i];
        { const int rn = (row + NGW < BL) ? row + NGW : row;
#pragma unroll
          for (int i = 0; i < 4; ++i) vn[i] = *(const f32x4*)(H + (size_t)rn * D + i * 256 + lane * 4); }
        float ss = 0.f;
#pragma unroll
        for (int i = 0; i < 4; ++i) ss += v[i][0] * v[i][0] + v[i][1] * v[i][1] + v[i][2] * v[i][2] + v[i][3] * v[i][3];
        ss = wave_sum_all(ss);
        const float rs = rsqrtf(ss * (1.0f / D) + 1e-6f);
        float lg[NE];
#pragma unroll
        for (int e = 0; e < NE; ++e) lg[e] = 0.f;
#pragma unroll
        for (int i = 0; i < 4; ++i) {
            const f32x4 o = v[i] * rs * gq[i];
            u32x2 w; w.x = pack2(o[0], o[1]); w.y = pack2(o[2], o[3]); *(u32x2*)(U + (size_t)row * D + i * 256 + lane * 4) = w;
#pragma unroll
            for (int e = 0; e < NE; ++e) { const f32x4 w4 = *(const LAS f32x4*)(RT + e * D + i * 256 + lane * 4); lg[e] += o[0] * w4[0] + o[1] * w4[1] + o[2] * w4[2] + o[3] * w4[3]; }
        }
        float r8[8], r4[4], r2[2], r1;
#pragma unroll
        for (int j = 0; j < 8; ++j) { const float a = lg[j], c2 = lg[8 + j]; const bool up = (lane & 32) != 0; r8[j] = (up ? c2 : a) + xchg32(up ? a : c2, up); }
#pragma unroll
        for (int j = 0; j < 4; ++j) { const float a = r8[j], c2 = r8[4 + j]; const bool up = (lane & 16) != 0; r4[j] = (up ? c2 : a) + xchg16(up ? a : c2, up); }
#pragma unroll
        for (int j = 0; j < 2; ++j) { const float a = r4[j], c2 = r4[2 + j]; const bool up = (lane & 8) != 0; r2[j] = (up ? c2 : a) + dpprm(up ? a : c2); }
        { const float a = r2[0], c2 = r2[1]; const bool up = (lane & 4) != 0; r1 = (up ? c2 : a) + dpphm(up ? a : c2); }
        r1 += dppq2(r1); r1 += dppq1(r1);
        float mx = r1;
        mx = fmaxf(mx, dpphm(mx)); mx = fmaxf(mx, dpprm(mx)); mx = fmaxf(mx, xchg16(mx, (lane & 16) != 0)); mx = fmaxf(mx, xchg32(mx, (lane & 32) != 0));
        const float ex = __expf(r1 - mx);
        float sum = ex;
        sum += dpphm(sum); sum += dpprm(sum); sum += xchg16(sum, (lane & 16) != 0); sum += xchg32(sum, (lane & 32) != 0);
        const float mine = ex / sum;
        const int eidx = ((lane >> 5) & 1) * 8 + ((lane >> 4) & 1) * 4 + ((lane >> 3) & 1) * 2 + ((lane >> 2) & 1);
        if ((lane & 3) == 0) AFF[((size_t)b * NE + eidx) * L + l] = mine;
    }
    __syncthreads();
}

__device__ __forceinline__ void phase_topk(const Params& p, LAS unsigned char* lds) {
    const int tid = tid_opaque(), wid = __builtin_amdgcn_readfirstlane(tid >> 6), lane = tid & 63;
    unsigned char* ws = p.ws;
    const float* AFF = (const float*)(ws + WS_AFF); float* GATEW = (float*)(ws + WS_GATEW); int* SEL = (int*)(ws + WS_SEL); int* IDX = (int*)(ws + WS_IDX);
    constexpr int NJ = 33;
    for (int item = blockIdx.x + wid * gridDim.x; item < NB * NE; item += gridDim.x * NWAVES) {
        const int b = item / NE, e = item % NE;
        const float* a = AFF + ((size_t)b * NE + e) * L;
        unsigned u[NJ];
#pragma unroll
        for (int j = 0; j < NJ; ++j) { const int i = j * 64 + lane; u[j] = (i < L) ? __float_as_uint(a[i]) : 0u; }
        unsigned prefix = 0u;
#pragma unroll 1
        for (int bit = 30; bit >= 0; --bit) {
            const unsigned cand = prefix | (1u << bit);
            int c = 0;
#pragma unroll
            for (int j = 0; j < NJ; ++j) c += __popcll(__ballot(u[j] >= cand));
            if (c >= CAP) prefix = cand;
        }
        int ngt = 0;
#pragma unroll
        for (int j = 0; j < NJ; ++j) ngt += __popcll(__ballot(u[j] > prefix));
        const int need_eq = CAP - ngt;
        const unsigned long long lower = (lane == 0) ? 0ull : (~0ull >> (64 - lane));
        int base_gt = 0, base_eq = 0;
#pragma unroll
        for (int j = 0; j < NJ; ++j) {
            const int i = j * 64 + lane;
            const unsigned long long mgt = __ballot(u[j] > prefix), meq = __ballot(i < L && u[j] == prefix);
            const int pg = base_gt + __popcll(mgt & lower), pe = base_eq + __popcll(meq & lower);
            base_gt += __popcll(mgt); base_eq += __popcll(meq);
            int slot = -1;
            if (u[j] > prefix) slot = pg; else if (i < L && u[j] == prefix && pe < need_eq) slot = ngt + pe;
            const int row = b * L + i;
            if (i < L) {
                SEL[(size_t)row * NE + e] = (slot >= 0) ? b * CAP + slot : -1;
                if (slot >= 0) { GATEW[e * EM + b * CAP + slot] = __uint_as_float(u[j]); IDX[e * EM + b * CAP + slot] = row; }
            }
        }
    }
    __syncthreads();
}

__device__ __forceinline__ float half_sum32(float v) {
    v += __int_as_float(__builtin_amdgcn_update_dpp(0, __float_as_int(v), 0xB1, 0xF, 0xF, false));
    v += __int_as_float(__builtin_amdgcn_update_dpp(0, __float_as_int(v), 0x4E, 0xF, 0xF, false));
    v += __int_as_float(__builtin_amdgcn_update_dpp(0, __float_as_int(v), 0x141, 0xF, 0xF, false));
    v += __int_as_float(__builtin_amdgcn_update_dpp(0, __float_as_int(v), 0x140, 0xF, 0xF, false));
    v += xchg16(v, (threadIdx.x & 16) != 0);
    return v;
}
__device__ __forceinline__ void prep_a_item(const Params& p, int layer, int item, LAS unsigned char* lds) {
    const int tid = tid_opaque(), wid = __builtin_amdgcn_readfirstlane(tid >> 6), lane = tid & 63, r = lane & 31, hh = lane >> 5;
    unsigned char* ws = p.ws;
    const float* PAC = (const float*)(ws + R_PAC);
    LAS bf16_t* ACT = (LAS bf16_t*)lds;
    LAS float* RKV = (LAS float*)(lds + 25088);
    LAS float* RED = (LAS float*)(lds + 25088 + 98304);
    const int b = item / 65, t0 = (item % 65) * 32, nvalid = (L - t0) < 32 ? (L - t0) : 32;
    const float* mu = p.rw_shift + (size_t)layer * 2 * A_TOT;
    {
        f32x4 w[2][10], m0[2], m1[2];
#pragma unroll
        for (int k = 0; k < 2; ++k) {
            const int u = tid + k * NTHREADS, g = u / 288, c = (u - g * 288) * 4, lb0 = t0 + 8 * g - 1;
            const float* col = PAC + (size_t)(b * L) * PACW + c;
#pragma unroll
            for (int j = 0; j < 10; ++j) { const int l = lb0 + j; w[k][j] = (l >= 0 && l < L) ? *(const f32x4*)(col + (size_t)l * PACW) : (f32x4){0.f, 0.f, 0.f, 0.f}; }
            m0[k] = *(const f32x4*)(mu + c); m1[k] = *(const f32x4*)(mu + A_TOT + c);
        }
#pragma unroll
        for (int k = 0; k < 3; ++k) {
            const int u = tid + k * NTHREADS;
            if (k == 2) {
                if (u >= 1152) break;
                const int g = u / 288, c = (u - g * 288) * 4, lb0 = t0 + 8 * g - 1;
                const float* col = PAC + (size_t)(b * L) * PACW + c;
#pragma unroll
                for (int j = 0; j < 10; ++j) { const int l = lb0 + j; w[0][j] = (l >= 0 && l < L) ? *(const f32x4*)(col + (size_t)l * PACW) : (f32x4){0.f, 0.f, 0.f, 0.f}; }
                m0[0] = *(const f32x4*)(mu + c); m1[0] = *(const f32x4*)(mu + A_TOT + c);
            }
            const int kk = (k == 2) ? 0 : k;
            const int g = u / 288, c = (u - g * 288) * 4;
#pragma unroll
            for (int i = 0; i < 8; ++i) {
                const int tt = 8 * g + i;
                const f32x4 pc = w[kk][i + 1];
                f32x4 sft = pc + m0[kk] * (w[kk][i] - pc) + m1[kk] * (w[kk][i + 2] - pc);
                if (tt >= nvalid) sft = (f32x4){0.f, 0.f, 0.f, 0.f};
                if (c < 768) *(LAS f32x4*)(RKV + tt * 768 + c) = sft;
                else {
                    int ac;
                    if (c < 896) { ac = c - 768;
#pragma unroll
                        for (int j = 0; j < 4; ++j) { const float e2 = __expf(2.0f * sft[j]); sft[j] = 1.0f - 2.0f * rcp_(e2 + 1.0f); } }
                    else if (c < 1024) ac = 128 + (c - 896);
                    else { ac = 256 + (c - 1024);
#pragma unroll
                        for (int j = 0; j < 4; ++j) sft[j] = sigmoidf_(sft[j]); }
                    *(LAS u32x2*)(ACT + tt * 392 + ac) = (u32x2){pack2(sft[0], sft[1]), pack2(sft[2], sft[3])};
                }
            }
        }
    }
    __syncthreads();
    const int c = wid * 32 + r, h = wid >> 1;
    const bf16_t* lb = (const bf16_t*)(ws + WS_LORA) + (size_t)layer * 98304;
    f32x16 zf = zero16(), zb = zero16(), af = zero16(), ab = zero16(), gg = zero16();
#pragma unroll
    for (int ks = 0; ks < 4; ++ks) {
        const int ko = 16 * ks + 8 * hh;
        const LAS bf16_t* ap = ACT + r * 392 + ko;
        zf = MFMA32(*(const LAS bf16x8*)(ap), *(const bf16x8*)(lb + c * 64 + ko), zf);
        zb = MFMA32(*(const LAS bf16x8*)(ap + 64), *(const bf16x8*)(lb + 16384 + c * 64 + ko), zb);
        af = MFMA32(*(const LAS bf16x8*)(ap + 128), *(const bf16x8*)(lb + 32768 + c * 64 + ko), af);
        ab = MFMA32(*(const LAS bf16x8*)(ap + 192), *(const bf16x8*)(lb + 49152 + c * 64 + ko), ab);
    }
#pragma unroll
    for (int ks = 0; ks < 8; ++ks) { const int ko = 16 * ks + 8 * hh; gg = MFMA32(*(const LAS bf16x8*)(ACT + r * 392 + 256 + ko), *(const bf16x8*)(lb + 65536 + c * 128 + ko), gg); }
    const float w0f = p.rw_w0[(size_t)layer * 512 + c], w0b = p.rw_w0[(size_t)layer * 512 + 256 + c];
    const float a0f = p.rw_a0[(size_t)layer * 512 + c], a0b = p.rw_a0[(size_t)layer * 512 + 256 + c];
    const float kkc = p.rw_k_k[(size_t)layer * 256 + c], kac = p.rw_k_a[(size_t)layer * 256 + c], rkc = p.rw_r_k[(size_t)layer * 256 + c];
#pragma unroll
    for (int i = 0; i < 16; ++i) {
        const int tt = (i & 3) + 8 * (i >> 2) + 4 * hh;
        zf[i] = -0.6065306597126334f * sigmoidf_(w0f + zf[i]); zb[i] = -0.6065306597126334f * sigmoidf_(w0b + zb[i]);
        af[i] = sigmoidf_(a0f + af[i]); ab[i] = sigmoidf_(a0b + ab[i]);
        const float k = RKV[tt * 768 + 256 + c], rr = RKV[tt * 768 + c];
        const float kkr = k * kkc;
        const float kdsum = k * (2.0f + (af[i] + ab[i] - 2.0f) * kac);
        const float s1 = half_sum32(kkr * kkr), s2 = half_sum32(rr * kdsum * rkc);
        if (r == 0) { RED[tt * 8 + wid] = s1; RED[256 + tt * 8 + wid] = s2; }
    }
    __syncthreads();
    unsigned char* sb = ws + R_SCANIN + (size_t)(b * 4 + h) * SC_BH;
    float* BONUS = (float*)(ws + WS_BONUS); bf16_t* GATE = (bf16_t*)(ws + R_GATE);
    const int ch = c & 63;
#pragma unroll
    for (int g4 = 0; g4 < 4; ++g4) {
        const int tq0 = 8 * g4 + 4 * hh;
        if (tq0 < nvalid) {
            f32x4 lwf, lwb, kk4, kaf, kab; float rv[4], vv[4], kdf[4], kdb[4];
#pragma unroll
            for (int j = 0; j < 4; ++j) {
                const int i = 4 * g4 + j, tt = tq0 + j;
                const float k = RKV[tt * 768 + 256 + c];
                const float ss = RED[tt * 8 + wid] + RED[tt * 8 + (wid ^ 1)];
                const float kk = k * kkc / fmaxf(sqrtf(ss), 1e-12f);
                lwf[j] = zf[i]; lwb[j] = zb[i]; kk4[j] = kk; kaf[j] = kk * af[i]; kab[j] = kk * ab[i];
                rv[j] = RKV[tt * 768 + c]; vv[j] = RKV[tt * 768 + 512 + c];
                kdf[j] = k * (1.0f + (af[i] - 1.0f) * kac); kdb[j] = k * (1.0f + (ab[i] - 1.0f) * kac);
                const size_t row = (size_t)(b * L + t0 + tt);
                GATE[row * 256 + c] = f2bf(gg[i]);
                if (r == 0 && (wid & 1) == 0) BONUS[row * 4 + h] = RED[256 + tt * 8 + wid] + RED[256 + tt * 8 + wid + 1];
            }
            const size_t qi = ((size_t)((t0 + 16 + tq0) >> 2) * 64 + ch) * 4;
            *(f32x4*)(sb + 0 * SC_VF + qi * 4) = lwf; *(f32x4*)(sb + 1 * SC_VF + qi * 4) = lwb; *(f32x4*)(sb + 2 * SC_VF + qi * 4) = kk4;
            *(f32x4*)(sb + 3 * SC_VF + qi * 4) = kaf; *(f32x4*)(sb + 4 * SC_VF + qi * 4) = kab;
            unsigned char* hb = sb + 5 * SC_VF;
            *(u32x2*)(hb + 0 * SC_VH + qi * 2) = (u32x2){pack2(rv[0], rv[1]), pack2(rv[2], rv[3])};
            *(u32x2*)(hb + 1 * SC_VH + qi * 2) = (u32x2){pack2(vv[0], vv[1]), pack2(vv[2], vv[3])};
            *(u32x2*)(hb + 2 * SC_VH + qi * 2) = (u32x2){pack2(kdf[0], kdf[1]), pack2(kdf[2], kdf[3])};
            *(u32x2*)(hb + 3 * SC_VH + qi * 2) = (u32x2){pack2(kdb[0], kdb[1]), pack2(kdb[2], kdb[3])};
        }
    }
    __syncthreads();
}
__device__ __forceinline__ void prep_bc_item(const Params& p, int layer, int item, LAS unsigned char* lds) {
    const int tid = tid_opaque();
    unsigned char* ws = p.ws;
    const float* PAC = (const float*)(ws + R_PAC); const bf16_t* PB = (const bf16_t*)(ws + R_PB);
    bf16_t* QR = (bf16_t*)(ws + R_QR); bf16_t* KR = (bf16_t*)(ws + R_KR); bf16_t* VT = (bf16_t*)(ws + R_VT); float* GLAIN = (float*)(ws + R_GLAIN);
    LAS float* cs = (LAS float*)lds;
    LAS bf16_t* sv = (LAS bf16_t*)(lds + 16384);
    LAS float* adl = (LAS float*)(lds + 16384 + 65792);
    const int b = item / 33, l0 = (item % 33) * 64, nvalid = (L - l0) < 64 ? (L - l0) : 64;
    for (int idx = tid; idx < 2048; idx += NTHREADS) {
        const int tl = idx >> 5, d = idx & 31;
        const float inv = exp2f(-(float)d * (13.287712379549449f / 32.0f));
        const float ang = (float)(l0 + tl) * inv;
        const double xd = (double)ang; const double kq = rint(xd * 0.15915494309189535); const float rr = (float)(xd - kq * 6.283185307179586);
        cs[idx * 2] = __cosf(rr); cs[idx * 2 + 1] = __sinf(rr);
    }
    {
        u32x4 w8[8];
#pragma unroll
        for (int u = 0; u < 8; ++u) { const int idx = tid + u * NTHREADS, tl = idx >> 6, ch = idx & 63;
            w8[u] = (tl < nvalid) ? *(const u32x4*)(PB + (size_t)(b * L + l0 + tl) * B_TOT + 1024 + ch * 8) : (u32x4){0u, 0u, 0u, 0u}; }
#pragma unroll
        for (int u = 0; u < 8; ++u) { const int idx = tid + u * NTHREADS, tl = idx >> 6, ch = idx & 63;
            LAS unsigned* d = (LAS unsigned*)(sv + tl * 514 + ch * 8); d[0] = w8[u].x; d[1] = w8[u].y; d[2] = w8[u].z; d[3] = w8[u].w; }
    }
    {
        float a4[4];
#pragma unroll
        for (int u = 0; u < 4; ++u) { const int idx = tid + u * NTHREADS, tl = idx >> 5, r = idx & 31; a4[u] = (tl < nvalid) ? PAC[(size_t)(b * L + l0 + tl) * PACW + A_TOT + 768 + r] : 0.f; }
#pragma unroll
        for (int u = 0; u < 4; ++u) adl[tid + u * NTHREADS] = a4[u];
    }
    __syncthreads();
    const float qscale = 0.125f * 1.4426950408889634f;
#pragma unroll 1
    for (int it0 = 0; it0 < 8; it0 += 4) {
        u32x4 xa[4], xb[4];
#pragma unroll
        for (int u = 0; u < 4; ++u) {
            const int idx = tid + (it0 + u) * NTHREADS, d0 = (idx & 3) * 8, c = (idx >> 2) & 1, h = (idx >> 3) & 3, which = (idx >> 5) & 1, tl = idx >> 6;
            const bf16_t* src = PB + (size_t)(b * L + l0 + (tl < nvalid ? tl : 0)) * B_TOT + which * 512 + h * 128 + c * 64 + d0;
            xa[u] = *(const u32x4*)src; xb[u] = *(const u32x4*)(src + 32);
        }
#pragma unroll
        for (int u = 0; u < 4; ++u) {
            const int idx = tid + (it0 + u) * NTHREADS, d0 = (idx & 3) * 8, c = (idx >> 2) & 1, h = (idx >> 3) & 3, which = (idx >> 5) & 1, tl = idx >> 6;
            {
                const float sc = (tl < nvalid) ? (which ? 1.0f : qscale) : 0.f;
                const unsigned wa[4] = {xa[u].x, xa[u].y, xa[u].z, xa[u].w}, wb[4] = {xb[u].x, xb[u].y, xb[u].z, xb[u].w};
                unsigned oa[4], ob[4];
#pragma unroll
                for (int j = 0; j < 4; ++j) {
                    const float x1l = __uint_as_float(wa[j] << 16), x1h = __uint_as_float(wa[j] & 0xffff0000u), x2l = __uint_as_float(wb[j] << 16), x2h = __uint_as_float(wb[j] & 0xffff0000u);
                    const f32x4 cs4 = *(const LAS f32x4*)(cs + (tl * 32 + d0 + 2 * j) * 2);
                    oa[j] = pack2((x1l * cs4[0] - x2l * cs4[1]) * sc, (x1h * cs4[2] - x2h * cs4[3]) * sc);
                    ob[j] = pack2((x2l * cs4[0] + x1l * cs4[1]) * sc, (x2h * cs4[2] + x1h * cs4[3]) * sc);
                }
                bf16_t* dst = (which ? KR : QR) + ((size_t)((b * 4 + h) * 2 + c) * LQ + l0 + tl) * 64 + d0;
                *(u32x4*)dst = (u32x4){oa[0], oa[1], oa[2], oa[3]}; *(u32x4*)(dst + 32) = (u32x4){ob[0], ob[1], ob[2], ob[3]};
            }
        }
    }
    for (int idx = tid; idx < 512 * 8; idx += NTHREADS) {
        const int hdv = idx >> 3, ch = idx & 7;
        {
            unsigned w[4];
#pragma unroll
            for (int q = 0; q < 4; ++q) w[q] = (unsigned)sv[(ch * 8 + 2 * q) * 514 + hdv] | ((unsigned)sv[(ch * 8 + 2 * q + 1) * 514 + hdv] << 16);
            *(u32x4*)(VT + ((size_t)(b * 4) * 128 + hdv) * LQ + l0 + ch * 8) = (u32x4){w[0], w[1], w[2], w[3]};
        }
    }
    const float* gup = p.gl_gate_up + (size_t)layer * 2 * 16 * 128; const float* gb = p.gl_gate_b + (size_t)layer * 2 * 128;
    float laf[16], lab_[16], kx[16];
    float gw0[16], gw1[16];
    { const int cc = tid & 127;
#pragma unroll
      for (int r = 0; r < 16; ++r) { gw0[r] = gup[r * 128 + cc]; gw1[r] = gup[(16 + r) * 128 + cc]; } }
    const float gb0 = gb[tid & 127], gb1 = gb[128 + (tid & 127)];
    float qv[16];
#pragma unroll
    for (int i = 0; i < 16; ++i) { const int idx = tid + i * NTHREADS, tl = idx >> 7, cc = idx & 127; const size_t row = (size_t)(b * L + l0 + (tl < nvalid ? tl : 0));
        kx[i] = PAC[row * PACW + A_TOT + 128 + cc]; qv[i] = PAC[row * PACW + A_TOT + cc]; }
#pragma unroll
    for (int i = 0; i < 16; ++i) {
        const int idx = tid + i * NTHREADS, tl = idx >> 7, cc = idx & 127, h = cc >> 5, dk = cc & 31;
        laf[i] = 0.f; lab_[i] = 0.f;
        if (tl >= nvalid) kx[i] = 0.f;
        if (tl < nvalid) {
            const int l = l0 + tl;
            float z0 = gb0, z1 = gb1;
#pragma unroll
            for (int r = 0; r < 16; ++r) { z0 += adl[tl * 32 + r] * gw0[r]; z1 += adl[tl * 32 + 16 + r] * gw1[r]; }
            laf[i] = (fminf(z0, 0.f) - __logf(1.0f + __expf(-fabsf(z0)))) * 0.0625f; lab_[i] = (fminf(z1, 0.f) - __logf(1.0f + __expf(-fabsf(z1)))) * 0.0625f;
            float* o = GLAIN + ((size_t)(b * 4 + h) * L + l) * 128;
            o[dk] = qv[i] * 0.17677669529663687f;
            o[32 + dk] = kx[i]; o[64 + dk] = laf[i]; o[96 + dk] = lab_[i];
        }
    }
    __syncthreads();
    LAS float* LA = (LAS float*)lds;
    LAS float* KX = (LAS float*)(lds + 65536);
    LAS bf16_t* KET = (LAS bf16_t*)(lds + 65536);
    LAS bf16_t* VTG = (LAS bf16_t*)(lds + 102400);
#pragma unroll
    for (int i = 0; i < 16; ++i) { const int idx = tid + i * NTHREADS; LA[idx] = laf[i]; LA[8192 + idx] = lab_[i]; KX[idx] = kx[i]; }
    {
        f32x4 v8[8];
#pragma unroll
        for (int u = 0; u < 8; ++u) { const int idx = tid + u * NTHREADS, tl = idx >> 6, c4 = (idx & 63) * 4;
            v8[u] = (tl < nvalid) ? *(const f32x4*)(PAC + (size_t)(b * L + l0 + tl) * PACW + A_TOT + 256 + c4) : (f32x4){0.f, 0.f, 0.f, 0.f}; }
#pragma unroll
        for (int u = 0; u < 8; ++u) { const int idx = tid + u * NTHREADS, tl = idx >> 6, c4 = (idx & 63) * 4;
#pragma unroll
            for (int j = 0; j < 4; ++j) VTG[(c4 + j) * 72 + tl] = f2bf(v8[u][j]); }
    }
    __syncthreads();
    {
        const int colx = tid & 255, seg = tid >> 8, dir = colx >> 7, cc = colx & 127;
        LAS float* q = LA + dir * 8192 + cc;
        LAS float* SEG2 = (LAS float*)(lds + 139264);
        float run = 0.f;
        if (dir == 0) { for (int j = 0; j < 32; ++j) { const int tl = seg * 32 + j; run += q[tl * 128]; q[tl * 128] = run; } }
        else { for (int j = 31; j >= 0; --j) { const int tl = seg * 32 + j; run += q[tl * 128]; q[tl * 128] = run; } }
        SEG2[seg * 256 + colx] = run;
        __syncthreads();
        const float off = (dir == 0) ? (seg ? SEG2[colx] : 0.f) : (seg ? 0.f : SEG2[256 + colx]);
        if (off != 0.f || true) { for (int j = 0; j < 32; ++j) q[(seg * 32 + j) * 128] += off; }
    }
    __syncthreads();
    {
        float ke[32];
#pragma unroll
        for (int i = 0; i < 32; ++i) { const int idx = tid + i * NTHREADS, dir = idx >> 13, tl = (idx >> 7) & 63, cc = idx & 127;
            const LAS float* la = LA + dir * 8192 + cc;
            const float ref = dir ? la[0] : la[63 * 128];
            ke[i] = KX[tl * 128 + cc] * __expf(ref - la[tl * 128]); }
        if (tid < 256) { const int dir = tid >> 7, cc = tid & 127, h = cc >> 5, d = cc & 31; const LAS float* la = LA + dir * 8192 + cc;
            ((float*)(ws + R_GDEC))[((size_t)((b * 4 + h) * 33 + (l0 >> 6)) * 2 + dir) * 32 + d] = __expf(dir ? la[0] : la[63 * 128]); }
        __syncthreads();
#pragma unroll
        for (int i = 0; i < 32; ++i) { const int idx = tid + i * NTHREADS, dir = idx >> 13, tl = (idx >> 7) & 63, cc = idx & 127, h = cc >> 5, d = cc & 31;
            KET[((h * 2 + dir) * 32 + d) * 72 + tl] = f2bf(ke[i]); }
    }
    __syncthreads();
    {
        const int wid = __builtin_amdgcn_readfirstlane(tid >> 6), lane = tid & 63, r = lane & 31, hh = lane >> 5, h = wid >> 1, dir = wid & 1;
        const size_t ci = ((size_t)((b * 4 + h) * 33 + (l0 >> 6)) * 2 + dir);
        float* kv = (float*)(ws + R_GKV) + ci * 2048;
        bf16x8 af[4];
#pragma unroll
        for (int ks = 0; ks < 4; ++ks) af[ks] = *(const LAS bf16x8*)(KET + (wid * 32 + r) * 72 + 16 * ks + 8 * hh);
#pragma unroll
        for (int dvt = 0; dvt < 2; ++dvt) {
            f32x16 acc = zero16();
#pragma unroll
            for (int ks = 0; ks < 4; ++ks) acc = MFMA32(af[ks], *(const LAS bf16x8*)(VTG + (h * 64 + dvt * 32 + r) * 72 + 16 * ks + 8 * hh), acc);
#pragma unroll
            for (int i = 0; i < 16; ++i) kv[((i & 3) + 8 * (i >> 2) + 4 * hh) * 64 + dvt * 32 + r] = acc[i];
        }
    }
    __syncthreads();
}
__device__ __forceinline__ void phase_prep(const Params& p, int layer, LAS unsigned char* lds, int qdup = 0) {
    constexpr int NA = NB * 65, NBC = NB * 33;
    unsigned* ctr = (unsigned*)(p.ws + WS_CTL + WS_QCTR + (size_t)(layer * 8 + 0 + qdup * 4) * 64);
    for (int it = q_next(ctr, lds); it < NA + NBC; it = q_next(ctr, lds)) {
        if (it < NBC) prep_bc_item(p, layer, it, lds); else prep_a_item(p, layer, it - NBC, lds);
    }
}

__device__ __forceinline__ f32x4 rev4(const f32x4 v) { return (f32x4){v[3], v[2], v[1], v[0]}; }
__device__ __forceinline__ u32x2 rev4h(const u32x2 w) { return (u32x2){(w.y >> 16) | (w.y << 16), (w.x >> 16) | (w.x << 16)}; }
__device__ __forceinline__ bf16x8 acc_frag(const f32x16& X, const int s2, const bool neg) {
    union { bf16x8 v; unsigned u[4]; } f;
#pragma unroll
    for (int j = 0; j < 4; ++j) f.u[j] = pack2(X[8 * s2 + 2 * j], X[8 * s2 + 2 * j + 1]) ^ (neg ? 0x80008000u : 0u);
    return f.v;
}
__device__ __forceinline__ bf16x8 lds_frag_perm(const LAS bf16_t* p) {
    union { bf16x8 v; u32x2 h2[2]; } f;
    f.h2[0] = *(const LAS u32x2*)p; f.h2[1] = *(const LAS u32x2*)(p + 8);
    return f.v;
}

__device__ __forceinline__ void phase_rwkv_a(const Params& p, LAS unsigned char* lds) {
    const int tid0 = tid_opaque(), wid = __builtin_amdgcn_readfirstlane(tid0 >> 6);
    unsigned char* ws = p.ws;
    const int gw = blockIdx.x * NWAVES + wid, NGW = gridDim.x * NWAVES;
    for (int item = gw; item < 64 * RW_NCH; item += NGW) {
        int tid = tid0; asm volatile("" : "+v"(tid));
        const int lane = tid & 63, r = lane & 31, hh = lane >> 5;
        unsigned ldsoff = (unsigned)(tid >> 6) * 18432u;
        LAS bf16_t* M0 = (LAS bf16_t*)(lds + ldsoff);
        LAS float* Lm = (LAS float*)(lds + ldsoff);
        unsigned char* img = ws + WS_RWC + (size_t)item * RWC_BYTES + (size_t)(hh * 272 + r) * 2; asm volatile("" : "+v"(img));
        GAS bf16_t* imgG = (GAS bf16_t*)img; GAS bf16_t* imgP2 = (GAS bf16_t*)(img + 8704); GAS bf16_t* imgH = (GAS bf16_t*)(img + 13056); GAS bf16_t* imgB2 = (GAS bf16_t*)(img + 21248);
        __builtin_amdgcn_sched_barrier(0);
        const int combo = item / RW_NCH, n = item - combo * RW_NCH, dir = combo >> 5, bh = combo & 31;
        const unsigned char* sbase = ws + R_SCANIN + (size_t)bh * SC_BH;
        GAS bf16_t* p2row = (GAS bf16_t*)(ws + WS_RWC + (size_t)item * RWC_BYTES + 8704) + lane;
        float g = 0.f;
        unsigned pKK[16], pAG[16], pKG[16], pV[16];
#pragma unroll
        for (int h2 = 0; h2 < 2; ++h2) {
            f32x4 lw4[4], kk4[4], ka4[4]; u32x2 r2[4], kd2[4], v2[4];
#pragma unroll
            for (int qd = 0; qd < 4; ++qd) {
                const int Q = h2 * 4 + qd, gq = dir ? (519 - 8 * n - Q) : (8 * n + 4 + Q);
                const size_t qi = ((size_t)gq * 64 + lane) * 4;
                lw4[qd] = gload16f(sbase + (size_t)dir * SC_VF + qi * 4); kk4[qd] = gload16f(sbase + 2 * SC_VF + qi * 4); ka4[qd] = gload16f(sbase + (size_t)(3 + dir) * SC_VF + qi * 4);
                r2[qd] = gload8(sbase + 5 * SC_VF + qi * 2); kd2[qd] = gload8(sbase + 5 * SC_VF + (size_t)(2 + dir) * SC_VH + qi * 2);
                v2[qd] = gload8(sbase + 5 * SC_VF + SC_VH + qi * 2);
            }
            if (dir) {
#pragma unroll
                for (int qd = 0; qd < 4; ++qd) { lw4[qd] = rev4(lw4[qd]); kk4[qd] = rev4(kk4[qd]); ka4[qd] = rev4(ka4[qd]); r2[qd] = rev4h(r2[qd]); kd2[qd] = rev4h(kd2[qd]); v2[qd] = rev4h(v2[qd]); }
            }
#pragma unroll
            for (int qd = 0; qd < 4; ++qd) {
                float okk[4], oag[4], okg[4];
#pragma unroll
                for (int k = 0; k < 4; ++k) {
                    const int t = h2 * 16 + qd * 4 + k, tau = n * 32 + t; const bool valid = tau < L;
                    float lw = lw4[qd][k], kk = kk4[qd][k], ka = ka4[qd][k];
                    const unsigned rw = (k >> 1) ? r2[qd].y : r2[qd].x, kw = (k >> 1) ? kd2[qd].y : kd2[qd].x;
                    float rr = __uint_as_float((k & 1) ? (rw & 0xffff0000u) : (rw << 16)), kd = __uint_as_float((k & 1) ? (kw & 0xffff0000u) : (kw << 16));
                    if (!valid) { lw = 0.f; kk = 0.f; ka = 0.f; rr = 0.f; kd = 0.f; }
                    const float egp = __expf(g); g += lw; const float eg = __expf(g), eng = rcp_(eg);
                    const bf16_t rgb = f2bf(rr * eg);
                    okk[k] = kk * egp; okg[k] = kd * eng; oag[k] = ka * eng;
                    p2row[t * 68] = rgb;
                    M0[6912 + t * 72 + lane] = rgb;
                }
                const int pi = (h2 * 16 + qd * 4) >> 1;
                pKK[pi] = pack2(okk[0], okk[1]); pKK[pi + 1] = pack2(okk[2], okk[3]); pAG[pi] = pack2(oag[0], oag[1]); pAG[pi + 1] = pack2(oag[2], oag[3]);
                pKG[pi] = pack2(okg[0], okg[1]); pKG[pi + 1] = pack2(okg[2], okg[3]);
                const bool v0ok = n * 32 + h2 * 16 + qd * 4 < L;
                pV[pi] = v0ok ? v2[qd].x : 0u; pV[pi + 1] = v0ok ? v2[qd].y : 0u;
#pragma unroll
                for (int k = 0; k < 4; ++k) { const int t = h2 * 16 + qd * 4 + k; const unsigned wkk = pKK[pi + (k >> 1)], wkg = pKG[pi + (k >> 1)], wag = pAG[pi + (k >> 1)];
                    M0[t * 72 + lane] = (bf16_t)((k & 1) ? (wkk >> 16) : (wkk & 0xffffu)); M0[2304 + t * 72 + lane] = (bf16_t)((k & 1) ? (wkg >> 16) : (wkg & 0xffffu)); M0[4608 + t * 72 + lane] = (bf16_t)((k & 1) ? (wag >> 16) : (wag & 0xffffu)); }
            }
        }
        const float gC = g;
        asm volatile("" ::: "memory");
        __builtin_amdgcn_sched_barrier(0);
        f32x16 Xa = zero16(), Xk = zero16(), Xrk = zero16(), Xra = zero16();
#pragma unroll
        for (int ks = 0; ks < 4; ++ks) {
            const int o = r * 72 + 16 * ks + 8 * hh;
            const bf16x8 aAg = *(const LAS bf16x8*)(M0 + 4608 + o), aKg = *(const LAS bf16x8*)(M0 + 2304 + o), bKK = *(const LAS bf16x8*)(M0 + o), bRg = *(const LAS bf16x8*)(M0 + 6912 + o);
            Xa = MFMA32(aAg, bKK, Xa); Xk = MFMA32(aKg, bKK, Xk); Xrk = MFMA32(aKg, bRg, Xrk); Xra = MFMA32(aAg, bRg, Xra);
        }
#pragma unroll
        for (int i = 0; i < 16; ++i) { const int sl = (i & 3) + 8 * (i >> 2) + 4 * hh;
            const bool strict = sl < r, incl = sl <= r;
            Xa[i] = strict ? Xa[i] : 0.f; Xk[i] = strict ? Xk[i] : 0.f; Xrk[i] = incl ? Xrk[i] : 0.f; Xra[i] = incl ? Xra[i] : 0.f; }
        bf16x8 fXk[2], fXrk[2], fXraN[2];
#pragma unroll
        for (int s2 = 0; s2 < 2; ++s2) { fXk[s2] = acc_frag(Xk, s2, false); fXrk[s2] = acc_frag(Xrk, s2, false); fXraN[s2] = acc_frag(Xra, s2, true); }
        __builtin_amdgcn_sched_barrier(0);
        __builtin_amdgcn_sched_barrier(0);
        asm volatile("" ::: "memory");
#pragma unroll
        for (int i = 0; i < 16; ++i) Lm[((i & 3) + 8 * (i >> 2) + 4 * hh) * 32 + r] = Xa[i];
        __builtin_amdgcn_sched_barrier(0);
        asm volatile("" ::: "memory");
        float Tr[32];
#pragma unroll
        for (int j = 31; j >= 0; --j) {
            float acc = (r == j) ? 1.f : 0.f;
#pragma unroll
            for (int s_ = j + 1; s_ < 32; ++s_) acc -= Tr[s_] * Lm[j * 32 + s_];
            asm volatile("" : "+v"(acc) :: "memory");
            Tr[j] = acc;
        }
        __builtin_amdgcn_sched_barrier(0);
        bf16x8 aT[2];
#pragma unroll
        for (int s2 = 0; s2 < 2; ++s2) {
            union { bf16x8 v; unsigned u[4]; } f;
#pragma unroll
            for (int jj = 0; jj < 4; ++jj) {
                const int j0 = 2 * jj, j1 = 2 * jj + 1;
                const float lo = hh ? Tr[16 * s2 + 8 * (j0 >> 2) + 4 + (j0 & 3)] : Tr[16 * s2 + 8 * (j0 >> 2) + (j0 & 3)];
                const float hi = hh ? Tr[16 * s2 + 8 * (j1 >> 2) + 4 + (j1 & 3)] : Tr[16 * s2 + 8 * (j1 >> 2) + (j1 & 3)];
                f.u[jj] = pack2(lo, hi);
            }
            aT[s2] = f.v;
        }
        __builtin_amdgcn_sched_barrier(0);
        asm volatile("" ::: "memory");
        {
            const float egc2 = __expf(gC);
#pragma unroll
            for (int q4 = 0; q4 < 8; ++q4) {
                unsigned ae[2], ke[2];
#pragma unroll
                for (int u = 0; u < 2; ++u) { const unsigned wa = pAG[2 * q4 + u], wk = pKG[2 * q4 + u];
                    ae[u] = pack2(__uint_as_float(wa << 16) * egc2, __uint_as_float(wa & 0xffff0000u) * egc2); ke[u] = pack2(__uint_as_float(wk << 16) * egc2, __uint_as_float(wk & 0xffff0000u) * egc2); }
                *(LAS u32x2*)(M0 + lane * 36 + 4 * q4) = (u32x2){pKK[2 * q4], pKK[2 * q4 + 1]};
                *(LAS u32x2*)(M0 + 2304 + lane * 36 + 4 * q4) = (u32x2){ae[0], ae[1]};
                *(LAS u32x2*)(M0 + 4608 + lane * 36 + 4 * q4) = (u32x2){ke[0], ke[1]};
                *(LAS u32x2*)(M0 + 6912 + lane * 36 + 4 * q4) = (u32x2){pV[2 * q4], pV[2 * q4 + 1]};
            }
        }
        __builtin_amdgcn_sched_barrier(0);
        asm volatile("" ::: "memory");
        f32x16 P1[2];
#pragma unroll
        for (int dt = 0; dt < 2; ++dt) { P1[dt] = zero16();
#pragma unroll
            for (int s2 = 0; s2 < 2; ++s2) P1[dt] = MFMA32(aT[s2], lds_frag_perm(M0 + (dt * 32 + r) * 36 + 16 * s2 + 4 * hh), P1[dt]); }
        __builtin_amdgcn_sched_barrier(0);
        bf16x8 fP1[2][2];
#pragma unroll
        for (int dt = 0; dt < 2; ++dt)
#pragma unroll
            for (int s2 = 0; s2 < 2; ++s2) fP1[dt][s2] = acc_frag(P1[dt], s2, false);
        asm volatile("s_waitcnt vmcnt(0)" ::: "memory");
#pragma unroll
        for (int dt = 0; dt < 2; ++dt) {
            f32x16 Cc = zero16();
#pragma unroll
            for (int s2 = 0; s2 < 2; ++s2) Cc = MFMA32(fXraN[s2], fP1[dt][s2], Cc);
#pragma unroll
            for (int i = 0; i < 16; ++i) Cc[i] += bf2f(imgP2[((i & 3) + 8 * (i >> 2)) * 68 + dt * 32]);
#pragma unroll
            for (int i = 0; i < 16; ++i) imgP2[((i & 3) + 8 * (i >> 2)) * 68 + dt * 32] = f2bf(Cc[i]);
        }
        __builtin_amdgcn_sched_barrier(0);
        {
            const float egc = __expf(gC);
#pragma unroll
            for (int dtc = 0; dtc < 2; ++dtc) {
                const float egcol = __shfl(egc, dtc * 32 + r);
#pragma unroll
                for (int dt = 0; dt < 2; ++dt) {
                    f32x16 Ga = zero16();
#pragma unroll
                    for (int s2 = 0; s2 < 2; ++s2) Ga = MFMA32(lds_frag_perm(M0 + 2304 + (dt * 32 + r) * 36 + 16 * s2 + 4 * hh), fP1[dtc][s2], Ga);
#pragma unroll
                    for (int i = 0; i < 16; ++i) { const int dl = (i & 3) + 8 * (i >> 2) + 4 * hh;
                        const float dg = (dt == dtc && dl == r) ? egcol : 0.f;
                        imgG[(dt * 32 + (i & 3) + 8 * (i >> 2)) * 68 + dtc * 32] = f2bf(dg - Ga[i]); }
                }
            }
        }
        __builtin_amdgcn_sched_barrier(0);
        bf16x8 fB1[2][2];
#pragma unroll
        for (int vt = 0; vt < 2; ++vt) {
            f32x16 X1 = zero16();
#pragma unroll
            for (int s2 = 0; s2 < 2; ++s2) X1 = MFMA32(fXk[s2], lds_frag_perm(M0 + 6912 + (vt * 32 + r) * 36 + 16 * s2 + 4 * hh), X1);
            f32x16 B1 = zero16();
#pragma unroll
            for (int s2 = 0; s2 < 2; ++s2) B1 = MFMA32(aT[s2], acc_frag(X1, s2, false), B1);
#pragma unroll
            for (int s2 = 0; s2 < 2; ++s2) fB1[vt][s2] = acc_frag(B1, s2, false);
        }
        __builtin_amdgcn_sched_barrier(0);
#pragma unroll
        for (int vt = 0; vt < 2; ++vt) {
            f32x16 Ba = zero16();
#pragma unroll
            for (int s2 = 0; s2 < 2; ++s2) {
                Ba = MFMA32(fXrk[s2], lds_frag_perm(M0 + 6912 + (vt * 32 + r) * 36 + 16 * s2 + 4 * hh), Ba);
                Ba = MFMA32(fXraN[s2], fB1[vt][s2], Ba);
            }
            u32x4 w0, w1;
            w0.x = pack2(Ba[0], Ba[1]); w0.y = pack2(Ba[2], Ba[3]); w0.z = pack2(Ba[4], Ba[5]); w0.w = pack2(Ba[6], Ba[7]);
            w1.x = pack2(Ba[8], Ba[9]); w1.y = pack2(Ba[10], Ba[11]); w1.z = pack2(Ba[12], Ba[13]); w1.w = pack2(Ba[14], Ba[15]);
            GAS u32x4* d = (GAS u32x4*)(imgB2 - (hh * 272 + r) + (vt * 64 + lane) * 16); d[0] = w0; d[1] = w1;
        }
        __builtin_amdgcn_sched_barrier(0);
#pragma unroll
        for (int dt = 0; dt < 2; ++dt)
#pragma unroll
            for (int vt = 0; vt < 2; ++vt) {
                f32x16 Ha = zero16();
#pragma unroll
                for (int s2 = 0; s2 < 2; ++s2) {
                    Ha = MFMA32(lds_frag_perm(M0 + 4608 + (dt * 32 + r) * 36 + 16 * s2 + 4 * hh), lds_frag_perm(M0 + 6912 + (vt * 32 + r) * 36 + 16 * s2 + 4 * hh), Ha);
                    const bf16x8 ae = lds_frag_perm(M0 + 2304 + (dt * 32 + r) * 36 + 16 * s2 + 4 * hh);
                    union { bf16x8 v; unsigned u[4]; } na; na.v = ae; na.u[0] ^= 0x80008000u; na.u[1] ^= 0x80008000u; na.u[2] ^= 0x80008000u; na.u[3] ^= 0x80008000u;
                    Ha = MFMA32(na.v, fB1[vt][s2], Ha);
                }
                u32x4 w0, w1;
                w0.x = pack2(Ha[0], Ha[1]); w0.y = pack2(Ha[2], Ha[3]); w0.z = pack2(Ha[4], Ha[5]); w0.w = pack2(Ha[6], Ha[7]);
                w1.x = pack2(Ha[8], Ha[9]); w1.y = pack2(Ha[10], Ha[11]); w1.z = pack2(Ha[12], Ha[13]); w1.w = pack2(Ha[14], Ha[15]);
                GAS u32x4* d = (GAS u32x4*)(imgH - (hh * 272 + r) + ((dt * 2 + vt) * 64 + lane) * 16); d[0] = w0; d[1] = w1;
            }
        asm volatile("" ::: "memory");
    }
    __syncthreads();
}

__device__ __forceinline__ void rwkv_b_item(const Params& p, int combo, LAS unsigned char* lds) {
    const int tid = tid_opaque(), wid = __builtin_amdgcn_readfirstlane(tid >> 6), lane = tid & 63, r = lane & 31, hh = lane >> 5;
    unsigned char* ws = p.ws;
    float* YS2 = (float*)(ws + R_YS2);
    constexpr int GRP = 2, NGRP = (RW_NCH + GRP - 1) / GRP, GB = GRP * RWC_BYTES;
    {
        const int dir = combo >> 5, bh = combo & 31, b = bh >> 2, h = bh & 3;
        const unsigned char* src = ws + WS_RWC + (size_t)combo * RW_NCH * RWC_BYTES;
        const size_t total = (size_t)RW_NCH * RWC_BYTES;
        f32x16 Z[2]; Z[0] = zero16(); Z[1] = zero16();
        __syncthreads();
        for (int o = tid * 16; o < GB; o += NTHREADS * 16) *(LAS u32x4*)(lds + o) = *(const u32x4*)(src + o);
        __syncthreads();
        for (int gi = 0; gi < NGRP; ++gi) {
            u32x4 pre[7];
            const size_t noff = (size_t)(gi + 1) * GB;
#pragma unroll
            for (int q = 0; q < 7; ++q) { const size_t o = noff + (size_t)(q * NTHREADS + tid) * 16; pre[q] = (o + 16 <= total && (q * NTHREADS + tid) * 16 < GB) ? *(const u32x4*)(src + o) : (u32x4){0u, 0u, 0u, 0u}; }
            if (wid < 2) {
                const int vt = wid;
#pragma unroll 1
                for (int c = 0; c < GRP; ++c) {
                    const int n = gi * GRP + c;
                    if (n < RW_NCH) {
                        const LAS unsigned char* img = lds + (gi & 1) * GB + c * RWC_BYTES;
                        const LAS bf16_t* iG = (const LAS bf16_t*)img; const LAS bf16_t* iP2 = (const LAS bf16_t*)(img + 8704);
                        const LAS bf16_t* iH = (const LAS bf16_t*)(img + 13056); const LAS bf16_t* iB2 = (const LAS bf16_t*)(img + 21248);
                        bf16x8 zb[2][2];
#pragma unroll
                        for (int dt = 0; dt < 2; ++dt)
#pragma unroll
                            for (int s2 = 0; s2 < 2; ++s2) zb[dt][s2] = acc_frag(Z[dt], s2, false);
                        f32x16 Y;
                        { const LAS u32x4* bp = (const LAS u32x4*)(iB2 + (vt * 64 + lane) * 16); const u32x4 w0 = bp[0], w1 = bp[1];
                          const unsigned ww[8] = {w0.x, w0.y, w0.z, w0.w, w1.x, w1.y, w1.z, w1.w};
#pragma unroll
                          for (int j = 0; j < 8; ++j) { Y[2 * j] = __uint_as_float(ww[j] << 16); Y[2 * j + 1] = __uint_as_float(ww[j] & 0xffff0000u); } }
#pragma unroll
                        for (int dt = 0; dt < 2; ++dt)
#pragma unroll
                            for (int s2 = 0; s2 < 2; ++s2) Y = MFMA32(lds_frag_perm(iP2 + r * 68 + dt * 32 + 16 * s2 + 4 * hh), zb[dt][s2], Y);
#pragma unroll
                        for (int i = 0; i < 16; ++i) { const int tau = n * 32 + (i & 3) + 8 * (i >> 2) + 4 * hh;
                            if (tau < L) { const int l = dir ? (L - 1 - tau) : tau; YS2[((size_t)dir * BL + (size_t)b * L + l) * 256 + h * 64 + vt * 32 + r] = Y[i]; } }
                        f32x16 Zn[2];
#pragma unroll
                        for (int dt = 0; dt < 2; ++dt) {
                            { const LAS u32x4* hp = (const LAS u32x4*)(iH + ((dt * 2 + vt) * 64 + lane) * 16); const u32x4 w0 = hp[0], w1 = hp[1];
                              const unsigned ww[8] = {w0.x, w0.y, w0.z, w0.w, w1.x, w1.y, w1.z, w1.w};
#pragma unroll
                              for (int j = 0; j < 8; ++j) { Zn[dt][2 * j] = __uint_as_float(ww[j] << 16); Zn[dt][2 * j + 1] = __uint_as_float(ww[j] & 0xffff0000u); } }
#pragma unroll
                            for (int dc = 0; dc < 2; ++dc)
#pragma unroll
                                for (int s2 = 0; s2 < 2; ++s2) Zn[dt] = MFMA32(lds_frag_perm(iG + (dt * 32 + r) * 68 + dc * 32 + 16 * s2 + 4 * hh), zb[dc][s2], Zn[dt]);
                        }
                        Z[0] = Zn[0]; Z[1] = Zn[1];
                    }
                }
            }
            LAS unsigned char* dstb = lds + ((gi + 1) & 1) * GB;
#pragma unroll
            for (int q = 0; q < 7; ++q) { const int o = (q * NTHREADS + tid) * 16; if (o < GB) *(LAS u32x4*)(dstb + o) = pre[q]; }
            __syncthreads();
        }
    }
}

__device__ __forceinline__ void phase_gla(const Params& p, int layer, LAS unsigned char* lds) {
    const int tid = tid_opaque(), wid = __builtin_amdgcn_readfirstlane(tid >> 6), lane = tid & 63, r = lane & 31, hh = lane >> 5;
    unsigned char* ws = p.ws;
    const float* GLAIN = (const float*)(ws + R_GLAIN); const float* PAC = (const float*)(ws + R_PAC); bf16_t* MIX = (bf16_t*)(ws + WS_U);
    const float* GKV = (const float*)(ws + R_GKV); const float* GDEC = (const float*)(ws + R_GDEC);
    const float* ng = p.gl_norm_g + (size_t)layer * 64;
    LAS float* G = (LAS float*)lds;
    LAS bf16_t* ST = (LAS bf16_t*)(lds + 32768);
    LAS bf16_t* QD = (LAS bf16_t*)(lds + 43008);
    LAS bf16_t* KI = (LAS bf16_t*)(lds + 53248);
    LAS bf16_t* VTs = (LAS bf16_t*)(lds + 63488);
    LAS float* RO = (LAS float*)(lds + 72704);
    unsigned* gctr = (unsigned*)(p.ws + WS_CTL + WS_QCTR + (size_t)(layer * 8 + 3) * 64);
    for (int item = q_next(gctr, lds); item < NB * 4 * 33; item = q_next(gctr, lds)) {
        const int bh = item / 33, n = item % 33, b = bh >> 2, h = bh & 3, l0 = n * 64, nvalid = (L - l0) < 64 ? (L - l0) : 64;
        f32x4 st1[4], va = (f32x4){0.f, 0.f, 0.f, 0.f}, vb = va, gg0 = va, gg1 = va;
#pragma unroll
        for (int i = 0; i < 4; ++i) { const int idx = tid + i * NTHREADS, tl = idx >> 5, c4 = (idx & 31) * 4;
            st1[i] = (tl < nvalid) ? *(const f32x4*)(GLAIN + ((size_t)bh * L + l0 + tl) * 128 + c4) : (f32x4){0.f, 0.f, 0.f, 0.f}; }
        { const int tl = tid >> 3, dv8 = (tid & 7) * 8;
          if (tl < nvalid) { const float* vp = PAC + (size_t)(b * L + l0 + tl) * PACW + A_TOT + 256 + h * 64 + dv8; va = *(const f32x4*)vp; vb = *(const f32x4*)(vp + 4);
                             const float* gp = PAC + (size_t)(b * L + l0 + tl) * PACW + A_TOT + 512 + h * 64 + dv8; gg0 = *(const f32x4*)gp; gg1 = *(const f32x4*)(gp + 4); } }
        {
            f32x4 sf = (f32x4){0.f, 0.f, 0.f, 0.f}, sb = sf;
            const int d = tid >> 4;
            const float* kvb = GKV + (size_t)bh * 33 * 2 * 2048 + tid * 4; const float* dcb = GDEC + (size_t)bh * 33 * 2 * 32 + d;
#pragma unroll 1
            for (int m0 = 0; m0 < n; m0 += 16) {
                f32x4 kv[16]; float dc[16];
#pragma unroll
                for (int u = 0; u < 16; ++u) { const int m = (m0 + u < n) ? m0 + u : 0; kv[u] = *(const f32x4*)(kvb + (size_t)(m * 2) * 2048); dc[u] = dcb[(m * 2) * 32]; }
#pragma unroll
                for (int u = 0; u < 16; ++u) if (m0 + u < n) sf = sf * dc[u] + kv[u];
            }
#pragma unroll 1
            for (int m0 = 32; m0 > n; m0 -= 16) {
                f32x4 kv[16]; float dc[16];
#pragma unroll
                for (int u = 0; u < 16; ++u) { const int m = (m0 - u > n) ? m0 - u : 32; kv[u] = *(const f32x4*)(kvb + (size_t)(m * 2 + 1) * 2048); dc[u] = dcb[(m * 2 + 1) * 32]; }
#pragma unroll
                for (int u = 0; u < 16; ++u) if (m0 - u > n) sb = sb * dc[u] + kv[u];
            }
            const int dv0 = (tid & 15) * 4;
#pragma unroll
            for (int j = 0; j < 4; ++j) { ST[(dv0 + j) * 40 + d] = f2bf(sf[j]); ST[(64 + dv0 + j) * 40 + d] = f2bf(sb[j]); }
        }
#pragma unroll
        for (int i = 0; i < 4; ++i) { const int idx = tid + i * NTHREADS, tl = idx >> 5, c4 = (idx & 31) * 4; *(LAS f32x4*)(G + tl * 128 + c4) = st1[i]; }
        __syncthreads();
        {
            const int col = tid & 63, seg = tid >> 6, dir = col >> 5;
            LAS float* q = G + 64 + col;
            LAS float* SEGT = RO;
            float run = 0.f;
            if (dir == 0) { for (int j = 0; j < 8; ++j) { const int tl = seg * 8 + j; run += q[tl * 128]; q[tl * 128] = run; } }
            else { for (int j = 7; j >= 0; --j) { const int tl = seg * 8 + j; run += q[tl * 128]; q[tl * 128] = run; } }
            SEGT[seg * 64 + col] = run;
            __syncthreads();
            float off = 0.f;
            if (dir == 0) { for (int s_ = 0; s_ < seg; ++s_) off += SEGT[s_ * 64 + col]; }
            else { for (int s_ = 7; s_ > seg; --s_) off += SEGT[s_ * 64 + col]; }
#pragma unroll
            for (int j = 0; j < 8; ++j) q[(seg * 8 + j) * 128] += off;
        }
        __syncthreads();
        {
            const int tl = tid >> 3, d4 = (tid & 7) * 4;
            const f32x4 q4 = *(const LAS f32x4*)(G + tl * 128 + d4), k4 = *(const LAS f32x4*)(G + tl * 128 + 32 + d4);
            const f32x4 bf = *(const LAS f32x4*)(G + tl * 128 + 64 + d4), cb = *(const LAS f32x4*)(G + tl * 128 + 96 + d4);
            float qf[4], kf[4], qb[4], kb[4];
#pragma unroll
            for (int j = 0; j < 4; ++j) { const float e0 = __expf(bf[j]), e1 = __expf(cb[j]); qf[j] = q4[j] * e0; kf[j] = k4[j] * rcp_(e0); qb[j] = q4[j] * e1; kb[j] = k4[j] * rcp_(e1); }
            *(LAS u32x2*)(QD + tl * 40 + d4) = (u32x2){pack2(qf[0], qf[1]), pack2(qf[2], qf[3])};
            *(LAS u32x2*)(QD + (64 + tl) * 40 + d4) = (u32x2){pack2(qb[0], qb[1]), pack2(qb[2], qb[3])};
            *(LAS u32x2*)(KI + tl * 40 + d4) = (u32x2){pack2(kf[0], kf[1]), pack2(kf[2], kf[3])};
            *(LAS u32x2*)(KI + (64 + tl) * 40 + d4) = (u32x2){pack2(kb[0], kb[1]), pack2(kb[2], kb[3])};
            const int dv8 = (tid & 7) * 8;
#pragma unroll
            for (int j = 0; j < 4; ++j) { VTs[(dv8 + j) * 72 + tl] = f2bf(va[j]); VTs[(dv8 + 4 + j) * 72 + tl] = f2bf(vb[j]); }
        }
        __syncthreads();
        {
            const int dir = wid >> 2, tt = (wid >> 1) & 1, dvt = wid & 1;
            f32x16 O;
#pragma unroll
            for (int i = 0; i < 16; ++i) O[i] = 0.f;
            const LAS bf16_t* qd = QD + (dir * 64 + tt * 32 + r) * 40 + 8 * hh;
#pragma unroll
            for (int st = 0; st < 2; ++st) {
                const bool use = dir ? (st >= tt) : (st <= tt);
                if (use) {
                    f32x16 X;
#pragma unroll
                    for (int i = 0; i < 16; ++i) X[i] = 0.f;
                    const LAS bf16_t* ki = KI + (dir * 64 + st * 32 + r) * 40 + 8 * hh;
#pragma unroll
                    for (int ks = 0; ks < 2; ++ks) X = __builtin_amdgcn_mfma_f32_32x32x16_bf16(*(const LAS bf16x8*)(ki + 16 * ks), *(const LAS bf16x8*)(qd + 16 * ks), X, 0, 0, 0);
                    if (st == tt) {
#pragma unroll
                        for (int i = 0; i < 16; ++i) { const int sl = (i & 3) + 8 * (i >> 2) + 4 * hh; const bool keep = dir ? (sl >= r) : (sl <= r); X[i] = keep ? X[i] : 0.f; }
                    }
#pragma unroll
                    for (int s2 = 0; s2 < 2; ++s2) {
                        union { bf16x8 v; unsigned u[4]; } pa;
#pragma unroll
                        for (int j = 0; j < 4; ++j) pa.u[j] = pack2(X[8 * s2 + 2 * j], X[8 * s2 + 2 * j + 1]);
                        union { bf16x8 v; u32x2 h2[2]; } vb;
                        const LAS bf16_t* vp = VTs + (dvt * 32 + r) * 72 + st * 32 + 16 * s2 + 4 * hh;
                        vb.h2[0] = *(const LAS u32x2*)vp; vb.h2[1] = *(const LAS u32x2*)(vp + 8);
                        O = __builtin_amdgcn_mfma_f32_32x32x16_bf16(pa.v, vb.v, O, 0, 0, 0);
                    }
                }
            }
            const LAS bf16_t* stp = ST + (dir * 64 + dvt * 32 + r) * 40 + 8 * hh;
#pragma unroll
            for (int ks = 0; ks < 2; ++ks) O = __builtin_amdgcn_mfma_f32_32x32x16_bf16(*(const LAS bf16x8*)(qd + 16 * ks), *(const LAS bf16x8*)(stp + 16 * ks), O, 0, 0, 0);
#pragma unroll
            for (int i = 0; i < 16; ++i) { const int tl = tt * 32 + (i & 3) + 8 * (i >> 2) + 4 * hh; RO[(dir * 64 + tl) * 64 + dvt * 32 + r] = O[i]; }
        }
        __syncthreads();
        {
            const int tl = tid >> 3, dv0 = (tid & 7) * 8;
            float o[8]; float ss = 0.f;
#pragma unroll
            for (int j = 0; j < 8; ++j) { o[j] = RO[tl * 64 + dv0 + j] + RO[(64 + tl) * 64 + dv0 + j]; ss += o[j] * o[j]; }
            ss += dppq1(ss); ss += dppq2(ss); ss += dpphm(ss);
            const float rs = rsqrtf(ss * (1.0f / 64.0f) + 1e-6f);
            if (tl < nvalid) {
                const size_t row = (size_t)(b * L + l0 + tl);
                const f32x4 g0 = gg0, g1 = gg1, n0 = *(const f32x4*)(ng + dv0), n1 = *(const f32x4*)(ng + dv0 + 4);
                float rr[8];
#pragma unroll
                for (int j = 0; j < 4; ++j) { rr[j] = o[j] * rs * n0[j] * (g0[j] * rcp_(1.0f + __expf(-g0[j]))); rr[4 + j] = o[4 + j] * rs * n1[j] * (g1[j] * rcp_(1.0f + __expf(-g1[j]))); }
                *(u32x4*)(MIX + row * D + 768 + h * 64 + dv0) = (u32x4){pack2(rr[0], rr[1]), pack2(rr[2], rr[3]), pack2(rr[4], rr[5]), pack2(rr[6], rr[7])};
            }
        }
        __syncthreads();
    }
}

__device__ __forceinline__ void phase_post(const Params& p, int layer) {
    const int tid = tid_opaque(), wid = tid >> 6, lane = tid & 63;
    const int gw = blockIdx.x * NWAVES + wid, NGW = gridDim.x * NWAVES;
    unsigned char* ws = p.ws;
    const float* YS2 = (const float*)(ws + R_YS2); const bf16_t* GATE = (const bf16_t*)(ws + R_GATE); const float* BONUS = (const float*)(ws + WS_BONUS);
    bf16_t* MIX = (bf16_t*)(ws + WS_U);
    const int h = lane >> 4, c = lane * 4;
    const f32x4 g4 = *(const f32x4*)(p.rw_gn_g + (size_t)layer * 256 + c), b4 = *(const f32x4*)(p.rw_gn_b + (size_t)layer * 256 + c);
    constexpr int RB = 4;
    for (int row0 = gw; row0 < BL; row0 += RB * NGW) {
        f32x4 yf[RB], yb[RB]; float vv[RB][4], bs[RB]; u32x2 gw2[RB];
#pragma unroll
        for (int u = 0; u < RB; ++u) {
            const int row = (row0 + u * NGW < BL) ? row0 + u * NGW : row0, b = row / L, l = row - b * L;
            yf[u] = *(const f32x4*)(YS2 + (size_t)row * 256 + c); yb[u] = *(const f32x4*)(YS2 + ((size_t)BL + row) * 256 + c);
            const bf16_t* vq = (const bf16_t*)(ws + R_SCANIN + (size_t)(b * 4 + h) * SC_BH + 5 * SC_VF + SC_VH) + ((size_t)((l + 16) >> 2) * 64 + (c & 63)) * 4 + ((l + 16) & 3);
            vv[u][0] = bf2f(vq[0]); vv[u][1] = bf2f(vq[4]); vv[u][2] = bf2f(vq[8]); vv[u][3] = bf2f(vq[12]);
            bs[u] = BONUS[(size_t)row * 4 + h];
            gw2[u] = *(const u32x2*)(GATE + (size_t)row * 256 + c);
        }
#pragma unroll
        for (int u = 0; u < RB; ++u) {
            const int row = row0 + u * NGW;
            if (row < BL) {
                const f32x4 o = yf[u] + yb[u];
                float sm = o[0] + o[1] + o[2] + o[3];
                sm = sum16(sm);
                const float mu = sm * (1.0f / 64.0f);
                const f32x4 dlt = o - mu;
                float q = dlt[0] * dlt[0] + dlt[1] * dlt[1] + dlt[2] * dlt[2] + dlt[3] * dlt[3];
                q = sum16(q);
                const float rstd = rsqrtf(q * (1.0f / 64.0f) + 64e-5f);
                const float gt[4] = {__uint_as_float(gw2[u].x << 16), __uint_as_float(gw2[u].x & 0xffff0000u), __uint_as_float(gw2[u].y << 16), __uint_as_float(gw2[u].y & 0xffff0000u)};
                float r[4];
#pragma unroll
                for (int j = 0; j < 4; ++j) r[j] = (dlt[j] * rstd * g4[j] + b4[j] + bs[u] * vv[u][j]) * gt[j];
                u32x2 w; w.x = pack2(r[0], r[1]); w.y = pack2(r[2], r[3]);
                *(u32x2*)(MIX + (size_t)row * D + c) = w;
            }
        }
    }
}

__device__ __forceinline__ void attn_item(const Params& p, int layer, int item, LAS unsigned char* lds) {
    const int tid = tid_opaque(), wid = __builtin_amdgcn_readfirstlane(tid >> 6), lane = tid & 63, r = lane & 31, hh = lane >> 5;
    const int qg = wid >> 1, c = wid & 1;
    unsigned char* ws = p.ws;
    const bf16_t* QR = (const bf16_t*)(ws + R_QR); const bf16_t* KR = (const bf16_t*)(ws + R_KR); const bf16_t* VT = (const bf16_t*)(ws + R_VT); bf16_t* MIX = (bf16_t*)(ws + WS_U);
    constexpr int TB = 36864;
    LAS bf16x8* Qs = (LAS bf16x8*)(lds + 3 * TB + wid * 4096);
    LAS float* X = (LAS float*)lds;
    const float* lp = p.df_lam + (size_t)layer * 256;
    const float s01 = wave_sum_all(lp[lane] * lp[64 + lane]), s23 = wave_sum_all(lp[128 + lane] * lp[192 + lane]);
    const float lam_init = layer == 0 ? 0.2f : 0.35550906759096915f;
    const float lam = __int_as_float(__builtin_amdgcn_readfirstlane(__float_as_int(__expf(s01) - __expf(s23) + lam_init)));
    const float* sg = p.df_subln_g + (size_t)layer * 128;
    {
        const int item_s = __builtin_amdgcn_readfirstlane(item);
        const int bh = item_s / 17, qb = item_s % 17, b = bh >> 2, h = bh & 3;
        const int q0 = qb * 128 + qg * 32;
#pragma unroll
        for (int ks = 0; ks < 4; ++ks) {
            bf16x8 qv = *(const bf16x8*)(QR + ((size_t)(bh * 2 + c) * LQ + (q0 + r < L ? q0 + r : 0)) * 64 + ks * 16 + hh * 8);
            if (q0 + r >= L) qv = (bf16x8){0, 0, 0, 0, 0, 0, 0, 0};
            Qs[ks * 64 + lane] = qv;
        }
        f32x16 O[4];
#pragma unroll
        for (int t = 0; t < 4; ++t)
#pragma unroll
            for (int i = 0; i < 16; ++i) O[t][i] = 0.f;
        float mrun = 0.f, lsum = 0.f;
        const int key = tid >> 3, ch = tid & 7, dvA = tid >> 3, dvB = (tid + NTHREADS) >> 3;
        const bf16_t* kp0 = KR + ((size_t)(bh * 2) * LQ + key) * 64 + ch * 8; const bf16_t* kp1 = kp0 + (size_t)LQ * 64;
        const bf16_t* vp0 = VT + ((size_t)bh * 128 + dvA) * LQ + ch * 8; const bf16_t* vp1 = VT + ((size_t)bh * 128 + dvB) * LQ + ch * 8;
        u32x4 pk0 = gload16(kp0), pk1 = gload16(kp1), pv0 = gload16(vp0), pv1 = gload16(vp1);
#define ATT_PARK(bufi) do { LAS bf16_t* Kw = (LAS bf16_t*)(lds + (bufi) * TB); LAS bf16_t* Vw = (LAS bf16_t*)(lds + (bufi) * TB + 18432); \
            *(LAS u32x4*)(Kw + key * 72 + ch * 8) = pk0; *(LAS u32x4*)(Kw + (64 + key) * 72 + ch * 8) = pk1; \
            const int vo_ = (ch >> 1) * 16 + (ch & 1) * 4;     \
            *(LAS u32x2*)(Vw + dvA * 72 + vo_) = (u32x2){pv0.x, pv0.y}; *(LAS u32x2*)(Vw + dvA * 72 + vo_ + 8) = (u32x2){pv0.z, pv0.w}; \
            *(LAS u32x2*)(Vw + dvB * 72 + vo_) = (u32x2){pv1.x, pv1.y}; *(LAS u32x2*)(Vw + dvB * 72 + vo_ + 8) = (u32x2){pv1.z, pv1.w}; } while (0)
#define ATT_FETCH(t_) do { const size_t ko = (size_t)(t_) * 64 * 64, vo = (size_t)(t_) * 64; \
            pk0 = gload16(kp0 + ko); pk1 = gload16(kp1 + ko); pv0 = gload16(vp0 + vo); pv1 = gload16(vp1 + vo); } while (0)
#define ATT_QK(dst, bufi) do { const LAS bf16_t* Kq = (const LAS bf16_t*)(lds + (bufi) * TB); \
            _Pragma("unroll") for (int ks = 0; ks < 4; ++ks) { const bf16x8 bq = Qs[ks * 64 + lane]; \
                _Pragma("unroll") for (int sub = 0; sub < 2; ++sub) { const bf16x8 a_ = *(const LAS bf16x8*)(Kq + (c * 64 + sub * 32 + r) * 72 + ks * 16 + hh * 8); \
                    dst[sub] = __builtin_amdgcn_mfma_f32_32x32x16_bf16(a_, bq, ks == 0 ? negm : dst[sub], 0, 0, 0); } } \
            __builtin_amdgcn_sched_group_barrier(0x100, 4, 0); \
            _Pragma("unroll") for (int i_ = 0; i_ < 8; ++i_) { __builtin_amdgcn_sched_group_barrier(0x008, 1, 0); __builtin_amdgcn_sched_group_barrier(0x100, 1, 0); } } while (0)
        f32x16 sA[2], sB[2], negm;
#pragma unroll
        for (int i = 0; i < 16; ++i) negm[i] = 0.f;
#define SB0() __builtin_amdgcn_sched_barrier(0)
#define ATT_KF(sub, ks) (*(const LAS bf16x8*)(Kq + (c * 64 + (sub) * 32 + r) * 72 + (ks) * 16 + hh * 8))
#define ATT_VF(f) (*(const LAS bf16x8*)(Vs + (((f) & 3) * 32 + r) * 72 + ((f) >> 2) * 16 + 8 * hh))
#define ATT_EXP2(S_, sub, i0) do { S_[sub][i0] = __builtin_amdgcn_exp2f(S_[sub][i0]); S_[sub][(i0) + 1] = __builtin_amdgcn_exp2f(S_[sub][(i0) + 1]); } while (0)
#define ATT_MAXSLOT(S_, T10_, T4_, f) do { \
            if ((f) >= 8 && (f) < 13) { const int i_ = (f) - 8; T10_[i_] = max3_(S_[0][3 * i_], S_[0][3 * i_ + 1], S_[0][3 * i_ + 2]); T10_[5 + i_] = max3_(S_[1][3 * i_], S_[1][3 * i_ + 1], S_[1][3 * i_ + 2]); } \
            if ((f) == 13) { T4_[0] = max3_(T10_[0], T10_[1], T10_[2]); T4_[1] = max3_(T10_[3], T10_[4], T10_[5]); } \
            if ((f) == 14) { T4_[2] = max3_(T10_[6], T10_[7], T10_[8]); T4_[3] = max3_(T10_[9], S_[0][15], S_[1][15]); } \
            if ((f) == 15) { T4_[2] = max3_(T4_[2], T4_[3], T4_[3]); T4_[0] = max3_(T4_[0], T4_[1], T4_[2]); } } while (0)
        float mxl;
        ATT_PARK(0); ATT_FETCH(1);
        __syncthreads();
        ATT_QK(sA, 0);
        asm volatile("s_nop 15\n\ts_nop 15\n\ts_nop 15\n\ts_nop 15" : "+v"(sA[0]), "+v"(sA[1]));
        { float t10[10], t4[4];
#pragma unroll
          for (int f = 8; f < 16; ++f) ATT_MAXSLOT(sA, t10, t4, f);
          mxl = t4[0]; }
        ATT_PARK(1); ATT_FETCH(2);
        int bc = 0, bn = 1, bw = 2;
#define ATT_STEP(SC, SN, KT, DOQK, MASKN) do { \
            __syncthreads();           \
            if ((KT) < 31) ATT_PARK(bw); \
            if ((KT) < 30) ATT_FETCH((KT) + 3); \
            const LAS bf16_t* Vs = (const LAS bf16_t*)(lds + bc * TB + 18432); \
            float mx; \
            { const auto sw = __builtin_amdgcn_permlane32_swap(__float_as_uint(mxl), __float_as_uint(mxl), false, false);        \
              mx = max3_(__uint_as_float(sw[0]), __uint_as_float(sw[1]), __uint_as_float(sw[1])); } \
              \
            if ((KT) == 0 || !__all(mx <= 8.0f)) { \
                const float d_ = ((KT) == 0) ? mx : fmaxf(mx, 0.f); \
                mrun += d_; \
                if ((KT) != 0) { \
                    const float alpha = __builtin_amdgcn_exp2f(-d_); \
                    lsum *= alpha; \
                    _Pragma("unroll") for (int t = 0; t < 4; ++t) \
                        _Pragma("unroll") for (int i = 0; i < 16; ++i) O[t][i] *= alpha; \
                } \
                _Pragma("unroll") for (int sub = 0; sub < 2; ++sub) \
                    _Pragma("unroll") for (int i = 0; i < 16; ++i) SC[sub][i] -= d_; \
                _Pragma("unroll") for (int i = 0; i < 16; ++i) negm[i] = -mrun; \
            } \
              \
              \
            bf16x8 vr[4]; \
            if (DOQK) { \
                const LAS bf16_t* Kq = (const LAS bf16_t*)(lds + bn * TB); \
                f32x16 c0 = negm, c1 = negm; \
                if (MASKN) { _Pragma("unroll") for (int i = 0; i < 16; ++i) { c1[i] = -1e30f; if (i >= 8) c0[i] = -1e30f; } }        \
                bf16x8 qa = Qs[lane], ka = ATT_KF(0, 0), kb = ATT_KF(1, 0), qb = Qs[64 + lane]; \
                ATT_EXP2(SC, 0, 0); SB0(); \
                SN[0] = __builtin_amdgcn_mfma_f32_32x32x16_bf16(ka, qa, c0, 0, 0, 0);    ka = ATT_KF(0, 1); ATT_EXP2(SC, 0, 2); SB0(); \
                SN[1] = __builtin_amdgcn_mfma_f32_32x32x16_bf16(kb, qa, c1, 0, 0, 0);    kb = ATT_KF(1, 1); ATT_EXP2(SC, 0, 4); SB0(); \
                SN[0] = __builtin_amdgcn_mfma_f32_32x32x16_bf16(ka, qb, SN[0], 0, 0, 0); qa = Qs[128 + lane]; ka = ATT_KF(0, 2); ATT_EXP2(SC, 0, 6); SB0(); \
                SN[1] = __builtin_amdgcn_mfma_f32_32x32x16_bf16(kb, qb, SN[1], 0, 0, 0); kb = ATT_KF(1, 2); ATT_EXP2(SC, 0, 8); SB0(); \
                SN[0] = __builtin_amdgcn_mfma_f32_32x32x16_bf16(ka, qa, SN[0], 0, 0, 0); qb = Qs[192 + lane]; ka = ATT_KF(0, 3); ATT_EXP2(SC, 0, 10); SB0(); \
                SN[1] = __builtin_amdgcn_mfma_f32_32x32x16_bf16(kb, qa, SN[1], 0, 0, 0); kb = ATT_KF(1, 3); ATT_EXP2(SC, 0, 12); SB0(); \
                SN[0] = __builtin_amdgcn_mfma_f32_32x32x16_bf16(ka, qb, SN[0], 0, 0, 0); vr[0] = ATT_VF(0); ATT_EXP2(SC, 0, 14); SB0(); \
                SN[1] = __builtin_amdgcn_mfma_f32_32x32x16_bf16(kb, qb, SN[1], 0, 0, 0); vr[1] = ATT_VF(1); vr[2] = ATT_VF(2); SB0(); \
            } else { \
                _Pragma("unroll") for (int q2 = 0; q2 < 8; ++q2) ATT_EXP2(SC, 0, 2 * q2); \
                vr[0] = ATT_VF(0); vr[1] = ATT_VF(1); vr[2] = ATT_VF(2); SB0(); \
            } \
            { float a16[16], a8[8], t10[10], t4[4]; \
              union { bf16x8 v; unsigned u[4]; } pb; \
              _Pragma("unroll") for (int f = 0; f < 16; ++f) { \
                  const int st = f >> 2, t = f & 3, sub = st >> 1, s2 = st & 1; \
                  if (f < 8) ATT_EXP2(SC, 1, 2 * f); \
                  if (t == 0) { _Pragma("unroll") for (int j = 0; j < 4; ++j) pb.u[j] = pack2(SC[sub][8 * s2 + 2 * j], SC[sub][8 * s2 + 2 * j + 1]); } \
                  O[t] = __builtin_amdgcn_mfma_f32_32x32x16_bf16(vr[f & 3], pb.v, O[t], 0, 0, 0); \
                  if (f + 3 < 16) vr[(f + 3) & 3] = ATT_VF(f + 3); \
                  a16[f] = SC[0][f] + SC[1][f]; \
                  if (f >= 8) a8[f - 8] = a16[f - 8] + a16[f]; \
                  if (DOQK) ATT_MAXSLOT(SN, t10, t4, f); \
                  SB0(); \
              } \
              if (DOQK) mxl = t4[0]; \
              lsum += ((a8[0] + a8[4]) + (a8[1] + a8[5])) + ((a8[2] + a8[6]) + (a8[3] + a8[7])); } \
            { const int t_ = bc; bc = bn; bn = bw; bw = t_; } } while (0)
#pragma unroll 1
        for (int kt = 0; kt < 30; kt += 2) { ATT_STEP(sA, sB, kt, true, false); ATT_STEP(sB, sA, kt + 1, true, false); }
        ATT_STEP(sA, sB, 30, true, false); ATT_STEP(sB, sA, 31, true, true);
        ATT_STEP(sA, sB, 32, false, false);
#undef ATT_STEP
#undef ATT_MAXSLOT
#undef ATT_EXP2
#undef ATT_VF
#undef ATT_KF
        const float lt = lsum + __shfl_xor(lsum, 32);
        const float inv = (c ? lam : 1.0f) / lt;
        __syncthreads();
        if (c == 1) {
#pragma unroll
            for (int t = 0; t < 4; ++t)
#pragma unroll
                for (int i = 0; i < 16; ++i) { const int dv = t * 32 + (i & 3) + 8 * (i >> 2) + 4 * hh; X[(qg * 128 + dv) * 32 + r] = O[t][i] * inv; }
        }
        __syncthreads();
        if (c == 0) {
            float ss = 0.f;
#pragma unroll
            for (int t = 0; t < 4; ++t)
#pragma unroll
                for (int i = 0; i < 16; ++i) { const int dv = t * 32 + (i & 3) + 8 * (i >> 2) + 4 * hh; const float o = O[t][i] * inv - X[(qg * 128 + dv) * 32 + r]; O[t][i] = o; ss += o * o; }
            ss += __shfl_xor(ss, 32);
            const float rn = rsqrtf(ss * (1.0f / 128.0f) + 1e-6f) * (1.0f - lam_init);
            const int q = q0 + r;
            if (q < L) {
                bf16_t* dst = MIX + (size_t)(b * L + q) * D + 256 + h * 128;
#pragma unroll
                for (int t = 0; t < 4; ++t)
#pragma unroll
                    for (int g = 0; g < 4; ++g) {
                        const int dv0 = t * 32 + 8 * g + 4 * hh;
                        const f32x4 g4 = *(const f32x4*)(sg + dv0);
                        u32x2 w; w.x = pack2(O[t][4 * g] * rn * g4[0], O[t][4 * g + 1] * rn * g4[1]); w.y = pack2(O[t][4 * g + 2] * rn * g4[2], O[t][4 * g + 3] * rn * g4[3]);
                        *(u32x2*)(dst + dv0) = w;
                    }
            }
        }
        __syncthreads();
    }
}

__device__ __forceinline__ void phase_mix(const Params& p, int layer, LAS unsigned char* lds, int qdup = 0) {
    const int x = blockIdx.x & 7;
    unsigned* ctr = (unsigned*)(p.ws + WS_CTL + WS_QCTR2 + (size_t)((layer * 2 + qdup) * 8 + x) * 64);
    unsigned* done = (unsigned*)(p.ws + WS_CTL + WS_QCTR + (size_t)(layer * 8 + 2 + qdup * 4) * 64);
    constexpr int NSB = 8, NAT = 4 * 17, NCV = CONV_NCHUNK / 8;
    for (int j = q_next(ctr, lds); j < NSB + NAT + NCV; j = q_next(ctr, lds)) {
        if (j < NSB) {
            rwkv_b_item(p, (j >> 2) * 32 + x * 4 + (j & 3), lds);
            __syncthreads();
            if (threadIdx.x == 0) __hip_atomic_fetch_add(done, 1u, __ATOMIC_RELAXED, __HIP_MEMORY_SCOPE_AGENT);
        } else if (j < NSB + NAT) { const int a_ = j - NSB; attn_item(p, layer, (x * 4 + a_ / 17) * 17 + a_ % 17, lds); }
        else {
            if (threadIdx.x == 0) { unsigned sp_ = 0; while (__hip_atomic_load(done, __ATOMIC_RELAXED, __HIP_MEMORY_SCOPE_AGENT) < 64u && ++sp_ < (1u << 24)) __builtin_amdgcn_s_sleep(8); }
            __syncthreads();
            conv_chunk(p, layer, x * NCV + (j - NSB - NAT), lds);
        }
    }
}

typedef float f32x4_t __attribute__((ext_vector_type(4)));
__device__ __forceinline__ f32x4 small_tile(const bf16_t* A, int lda, const bf16_t* Bt, int ldb, int K, int lane, const int* rowidx = nullptr) {
    const bf16_t* ap = A + (size_t)(rowidx ? rowidx[lane & 15] : (lane & 15)) * lda + 8 * (lane >> 4); const bf16_t* bp = Bt + (size_t)(lane & 15) * ldb + 8 * (lane >> 4);
    f32x4 acc = (f32x4){0.f, 0.f, 0.f, 0.f};
    bf16x8 a[4], b[4], an[4], bn[4];
#pragma unroll
    for (int u = 0; u < 4; ++u) { a[u] = *(const bf16x8*)(ap + 32 * u); b[u] = *(const bf16x8*)(bp + 32 * u); }
    for (int k0 = 0; k0 < K; k0 += 128) {
        const int kn = (k0 + 128 < K) ? k0 + 128 : k0;
#pragma unroll
        for (int u = 0; u < 4; ++u) { an[u] = *(const bf16x8*)(ap + kn + 32 * u); bn[u] = *(const bf16x8*)(bp + kn + 32 * u); }
#pragma unroll
        for (int u = 0; u < 4; ++u) acc = __builtin_amdgcn_mfma_f32_16x16x32_bf16(a[u], b[u], acc, 0, 0, 0);
#pragma unroll
        for (int u = 0; u < 4; ++u) { a[u] = an[u]; b[u] = bn[u]; }
    }
    return acc;
}
__device__ __forceinline__ void small_outproj(const Params& p, int layer) {
    const int tid = tid_opaque(), wid = tid >> 6, lane = tid & 63;
    unsigned char* ws = p.ws;
    const bf16_t* MIX = (const bf16_t*)(ws + WS_U); const bf16_t* W = (const bf16_t*)(ws + WS_WOUT) + (size_t)layer * D * D; float* H = (float*)(ws + WS_H);
    for (int item = blockIdx.x; item < 64; item += gridDim.x) {
        const int rg = item >> 3, cg = item & 7, row0 = 16384 + rg * 16, col0 = cg * 128 + wid * 16;
        const f32x4 acc = small_tile(MIX + (size_t)row0 * D, D, W + (size_t)col0 * D, D, D, lane);
#pragma unroll
        for (int j = 0; j < 4; ++j) { float* q = H + (size_t)(row0 + 4 * (lane >> 4) + j) * D + col0 + (lane & 15); *q += acc[j]; }
    }
}
__device__ __forceinline__ void small_moe1(const Params& p) {
    const int tid = tid_opaque(), wid = tid >> 6, lane = tid & 63;
    unsigned char* ws = p.ws;
    const bf16_t* XS = (const bf16_t*)(ws + R_XS); const bf16_t* W = (const bf16_t*)(ws + WS_W13); bf16_t* HID = (bf16_t*)(ws + R_HID);
    for (int item = blockIdx.x; item < NE * 11; item += gridDim.x) {
        const int e = item / 11, ft = item - e * 11;
        const bf16_t* A = (const bf16_t*)(ws + WS_U); const int* ri = (const int*)(ws + WS_IDX) + e * EM + 2048; const bf16_t* Bw = W + ((size_t)e * 2816 + ft * 256 + wid * 16) * D;
        const f32x4 a = small_tile(A, D, Bw, D, D, lane, ri), b = small_tile(A, D, Bw + (size_t)128 * D, D, D, lane, ri);
#pragma unroll
        for (int j = 0; j < 4; ++j) HID[((size_t)e * EM + 2048 + 4 * (lane >> 4) + j) * FF + ft * 128 + wid * 16 + (lane & 15)] = f2bf(a[j] * rcp_(1.0f + __expf(-a[j])) * b[j]);
    }
}
__device__ __forceinline__ void small_moe2(const Params& p) {
    const int tid = tid_opaque(), wid = tid >> 6, lane = tid & 63;
    unsigned char* ws = p.ws;
    const bf16_t* HID = (const bf16_t*)(ws + R_HID); const bf16_t* W = (const bf16_t*)(ws + WS_W2); bf16_t* YS = (bf16_t*)(ws + R_YS); const float* GW = (const float*)(ws + WS_GATEW);
    for (int item = blockIdx.x; item < NE * 8; item += gridDim.x) {
        const int e = item >> 3, cg = item & 7, col0 = cg * 128 + wid * 16;
        const f32x4 acc = small_tile(HID + ((size_t)e * EM + 2048) * FF, FF, W + ((size_t)e * D + col0) * FF, FF, FF, lane);
#pragma unroll
        for (int j = 0; j < 4; ++j) { const size_t row = (size_t)e * EM + 2048 + 4 * (lane >> 4) + j; YS[row * D + col0 + (lane & 15)] = f2bf(acc[j] * GW[row]); }
    }
}

#define XB_TMO      128
#define XB_XCNT(j)  (256  + 64 * (j))
#define XB_XSUB(j)  (1280 + 64 * (j))
#define XB_XGEN(j)  (2304 + 64 * (j))
#define XB_TOP      3328
#define XB_TOPGEN   3392
#define XCD_BAR_WORDS 3456
#define XB_SPIN_CAP (1u << 22)
__device__ __forceinline__ unsigned xb_ld(unsigned* p)              { return __hip_atomic_load(p, __ATOMIC_RELAXED, __HIP_MEMORY_SCOPE_AGENT); }
__device__ __forceinline__ unsigned xb_add(unsigned* p, unsigned v) { return __hip_atomic_fetch_add(p, v, __ATOMIC_RELAXED, __HIP_MEMORY_SCOPE_AGENT); }
__device__ __forceinline__ unsigned xb_xcc_id() { return (unsigned)__builtin_amdgcn_s_getreg((3 << 11) | 20) & 0xFu; }
#define XB_SPIN(cond, bar) do { unsigned _sp = 0; while (cond) { __builtin_amdgcn_s_sleep(1); \
    if ((++_sp & 255u) == 0u) { if (xb_ld(&(bar)[XB_TMO])) break; if (_sp > XB_SPIN_CAP) { atomicAdd(&(bar)[XB_TMO], 1u); break; } } } } while (0)
struct XcdBarrier { unsigned* bar; unsigned x; volatile LAS unsigned* st; };
__device__ __forceinline__ XcdBarrier xcd_barrier_post(unsigned* bar, volatile LAS unsigned* st) {
    XcdBarrier b; b.bar = bar; b.x = xb_xcc_id(); b.st = st;
    if (threadIdx.x == 0) (void)xb_add(&bar[XB_XCNT(b.x)], 1u);
    return b;
}
__device__ __forceinline__ void xcd_barrier_complete(unsigned* bar, unsigned x, unsigned& nloc, unsigned& nx) {
    const unsigned G = gridDim.x * gridDim.y * gridDim.z;
    unsigned sum, cnt, mine, sp = 0u;
    for (;;) {
        sum = 0u; cnt = 0u; mine = 0u;
#pragma unroll
        for (unsigned j = 0; j < 16; ++j) { const unsigned c = xb_ld(&bar[XB_XCNT(j)]); sum += c; cnt += (c > 0u) ? 1u : 0u; mine = (j == x) ? c : mine; }
        if (sum == G) break;
        __builtin_amdgcn_s_sleep(1);
        if ((++sp & 255u) == 0u) { if (xb_ld(&bar[XB_TMO])) break; if (sp > XB_SPIN_CAP) { atomicAdd(&bar[XB_TMO], 1u); break; } }
    }
    nloc = mine > 0u ? mine : 1u; nx = cnt > 0u ? cnt : 1u;
}
__device__ __forceinline__ void xcd_barrier(const XcdBarrier& b) {
    asm volatile("s_waitcnt vmcnt(0)" ::: "memory");
    __syncthreads();
    if (threadIdx.x == 0) {
        unsigned* bar = b.bar;
        __builtin_amdgcn_s_waitcnt(0);
        unsigned nloc = b.st[0], nx = b.st[1];
        if (nloc == 0u) { xcd_barrier_complete(bar, b.x, nloc, nx); b.st[0] = nloc; b.st[1] = nx; }
        const unsigned old = xb_add(&bar[XB_XSUB(b.x)], 1u);
        const unsigned gen = old / nloc;
        if (old + 1u == (gen + 1u) * nloc) {
            __builtin_amdgcn_fence(__ATOMIC_RELEASE, "agent");
            asm volatile("s_waitcnt vmcnt(0)" ::: "memory");
            const unsigned og = xb_add(&bar[XB_TOP], 1u);
            const unsigned tg = og / nx;
            if (og + 1u == (tg + 1u) * nx) xb_add(&bar[XB_TOPGEN], 1u);
            else XB_SPIN(xb_ld(&bar[XB_TOPGEN]) == tg, bar);
            __builtin_amdgcn_fence(__ATOMIC_ACQUIRE, "agent");
            xb_add(&bar[XB_XGEN(b.x)], 1u);
            asm volatile("s_waitcnt vmcnt(0)" ::: "memory");
        } else {
            XB_SPIN(xb_ld(&bar[XB_XGEN(b.x)]) == gen, bar);
            __builtin_amdgcn_fence(__ATOMIC_ACQUIRE, "agent");
            asm volatile("s_waitcnt vmcnt(0)" ::: "memory");
        }
    }
    __syncthreads();
}

constexpr int PH_PER_LAYER = 15, N_PHASES = 2 * PH_PER_LAYER + 1;
#ifndef DUP_PHASE
#define DUP_PHASE (-1)
#endif
#define RUN(kk, call) do { call; if (DUP_PHASE == (kk)) { xcd_barrier(bar); call; } } while (0)
#define NEWPHASE() do { ws = p.ws; asm volatile("" : "+s"(ws)); q.ws = ws; } while (0)
template <int LAYER>
__device__ __forceinline__ void layer_body(const Params& p, Params& q, LAS unsigned char* lds, const XcdBarrier& bar) {
    constexpr int layer = LAYER;
    unsigned char* ws;
    if (LAYER == 0) { NEWPHASE(); RUN(0, phase_conv(q, layer, 0, lds)); }
    else xcd_barrier(bar);
    NEWPHASE(); phase_norm1(q, layer, LAYER == 0 ? 0 : 1);
    xcd_barrier(bar); NEWPHASE();
    { pg8::Gemm g{(const bf16_t*)(ws + WS_U), (const bf16_t*)(ws + WS_WIN) + (size_t)layer * INP * D, MP, INP, D};
      pg8::StaticOrder S; S.init(MP, INP, gridDim.x, blockIdx.x); EpiInproj E{(float*)(ws + R_PAC), (bf16_t*)(ws + R_PB)};
      RUN(2, pg8::gemm_phase(lds, g, S, E)); }
    xcd_barrier(bar); NEWPHASE();
    phase_prep(q, layer, lds); if (DUP_PHASE == 3) { xcd_barrier(bar); phase_prep(q, layer, lds, 1); }
    xcd_barrier(bar); NEWPHASE();
    RUN(4, phase_rwkv_a(q, lds));
    NEWPHASE();
    RUN(5, phase_gla(q, layer, lds));
    xcd_barrier(bar); NEWPHASE();
    phase_mix(q, layer, lds); if (DUP_PHASE == 6) { xcd_barrier(bar); phase_mix(q, layer, lds, 1); }
    xcd_barrier(bar); NEWPHASE();
    RUN(8, phase_post(q, layer));
    xcd_barrier(bar); NEWPHASE();
    { pg8::Gemm g{(const bf16_t*)(ws + WS_U), (const bf16_t*)(ws + WS_WOUT) + (size_t)layer * D * D, MP, D, D};
      pg8::StaticOrder S; S.init(16384, D, gridDim.x, blockIdx.x); EpiResidual E{(float*)(ws + WS_H)};
      small_outproj(q, layer);
      pg8::gemm_phase(lds, g, S, E); }
    xcd_barrier(bar); NEWPHASE();
    RUN(10, phase_norm2(q, layer, lds));
    xcd_barrier(bar); NEWPHASE();
    RUN(11, phase_topk(q, lds));
    xcd_barrier(bar); NEWPHASE();
    { pg8::Gemm g{(const bf16_t*)(ws + WS_U), (const bf16_t*)(ws + WS_W13), NE * EM, NE * 2816, D};
      pg8::GroupOrder S; S.init(NE, 8, 11, 9, 4, gridDim.x, blockIdx.x); EpiSwiglu E{(bf16_t*)(ws + R_HID)};
      small_moe1(q);
      RUN(13, (pg8::gemm_phase<EpiSwiglu, pg8::GroupOrder, true>(lds, g, S, E, (const int*)(ws + WS_IDX)))); }
    xcd_barrier(bar); NEWPHASE();
    { pg8::Gemm g{(const bf16_t*)(ws + R_HID), (const bf16_t*)(ws + WS_W2), NE * EM, NE * D, FF};
      pg8::GroupOrder S; S.init(NE, 8, 4, 9, 4, gridDim.x, blockIdx.x); EpiDown E{(bf16_t*)(ws + R_YS), (const float*)(ws + WS_GATEW)};
      RUN(14, pg8::gemm_phase(lds, g, S, E));
      small_moe2(q); }
}
__global__ void __launch_bounds__(NTHREADS, 2) fwd_kernel(Params p) {
    extern __shared__ __attribute__((aligned(16))) unsigned char lds_raw[];
    LAS unsigned char* lds = (LAS unsigned char*)lds_raw;
    Params q = p;
    volatile LAS unsigned* bst = (volatile LAS unsigned*)(lds + LDS_MAIN);
    if (threadIdx.x < 16) bst[threadIdx.x] = 0u;
    __syncthreads();
    XcdBarrier bar = xcd_barrier_post((unsigned*)(p.ws + WS_CTL), bst);
    layer_body<0>(p, q, lds, bar);
    layer_body<1>(p, q, lds, bar);
    xcd_barrier(bar);
    { unsigned char* ws; NEWPHASE(); (void)ws; phase_norm1(q, 0, 2); }
}

#ifndef N_LAUNCH_MODE
#define N_LAUNCH_MODE 1
#endif
extern "C" void kernel_launch(void* const* d_in, const int* in_sizes, int n_in, void* d_out, int out_size, void* d_ws, size_t ws_size, hipStream_t stream) {
    static int grid = 0;
    if (grid == 0) {
        if (n_in != 27 || ws_size < WS_END) { fprintf(stderr, "kernel_launch: unexpected n_in %d or ws_size %zu < %zu\n", n_in, ws_size, (size_t)WS_END); grid = -1; return; }
        int dev = 0, cus = 0, per_cu = 0;
        hipGetDevice(&dev); hipDeviceGetAttribute(&cus, hipDeviceAttributeMultiprocessorCount, dev);
        if (hipFuncSetAttribute((const void*)fwd_kernel, hipFuncAttributeMaxDynamicSharedMemorySize, LDS_BYTES) != hipSuccess) { fprintf(stderr, "kernel_launch: hipFuncSetAttribute failed\n"); grid = -1; return; }
        hipOccupancyMaxActiveBlocksPerMultiprocessor(&per_cu, (const void*)fwd_kernel, NTHREADS, LDS_BYTES);
        if (per_cu < 1) { fprintf(stderr, "kernel_launch: occupancy query says %d blocks per CU\n", per_cu); per_cu = 1; }
        (void)hipGetLastError();
        grid = cus;
    }
    if (grid < 0) return;
    if (hipMemsetAsync((char*)d_ws + WS_CTL, 0, 32768, stream) != hipSuccess) { fprintf(stderr, "kernel_launch: memset failed\n"); return; }
    Params p{};
    const float** pp = (const float**)&p;
    for (int i = 0; i < 27; ++i) pp[i] = (const float*)d_in[i];
    p.out = (float*)d_out; p.ws = (unsigned char*)d_ws;
    p.ph_lo = 0; p.ph_hi = N_PHASES;
    hipLaunchKernelGGL(fwd_kernel, dim3(grid), dim3(NTHREADS), LDS_BYTES, stream, p);
    hipError_t e = hipPeekAtLastError();
    if (e != hipSuccess) fprintf(stderr, "launch failed: %s (grid %d)\n", hipGetErrorString(e), grid);
}
```
